# Optimizing an MI355X kernel written in HIP

```python
import math
import jax
import jax.numpy as jnp
from jax import lax
import numpy as np

D_MODEL = 1024
BATCH = 8
SEQ = 2048
DEPTH = 2
DEC_BATCH = 32
DEC_SEQ = 4
PAST_LEN = 8192
PAGE_SIZE = 128

EPS = 1e-6
NEG = -1e30
LB_FLOOR = 1e-30
D_A = D_MODEL // 2
CONV_W = 31
N_HEADS = 8
N_KV_HEADS = 2
HEAD_DIM = 64
D_B = N_HEADS * HEAD_DIM
KV_DIM = N_KV_HEADS * HEAD_DIM
IDX_HEADS = 4
IDX_DIM = 64
TOPK_MAX = 256
ROPE_THETA = 10000.0
Q_BLOCK = 128
C_HEADS = 4
C_KDIM = 128
C_VDIM = D_MODEL // 2 // C_HEADS
D_C = C_HEADS * C_VDIM
C_FDIM = C_HEADS * C_KDIM
CHUNK = 64

IN_SPLITS = (D_A, D_A, D_A,
             D_B, KV_DIM, KV_DIM, IDX_HEADS * IDX_DIM, IDX_DIM, IDX_HEADS, D_B,
             C_FDIM, C_FDIM, D_C, D_C,
             D_MODEL, D_MODEL, D_MODEL)
N_IN = sum(IN_SPLITS)

kernel_name = 'hybrid_conv_dsa_hgrn2_step'


def _rmsnorm(x, g=None):
    xf = x.astype(jnp.float32)
    y = xf * lax.rsqrt(jnp.mean(xf * xf, axis=-1, keepdims=True) + EPS)
    if g is not None:
        y = y * g.astype(jnp.float32)
    return y.astype(x.dtype)


def _layernorm(x, g, b):
    xf = x.astype(jnp.float32)
    mu = jnp.mean(xf, axis=-1, keepdims=True)
    var = jnp.mean(jnp.square(xf - mu), axis=-1, keepdims=True)
    y = (xf - mu) * lax.rsqrt(var + EPS) * g.astype(jnp.float32) + b.astype(jnp.float32)
    return y.astype(x.dtype)


def _rope(x, pos):
    half = x.shape[-1] // 2
    inv = ROPE_THETA ** (-jnp.arange(half, dtype=jnp.float32) / half)
    ang = pos.astype(jnp.float32)[:, None] * inv[None, :]
    cos = jnp.cos(ang)[None, :, None, :]
    sin = jnp.sin(ang)[None, :, None, :]
    xf = x.astype(jnp.float32)
    x1, x2 = xf[..., :half], xf[..., half:]
    return jnp.concatenate([x1 * cos - x2 * sin, x2 * cos + x1 * sin], axis=-1).astype(x.dtype)


def _split_in(z):
    offs = np.cumsum(IN_SPLITS)[:-1].tolist()
    return jnp.split(z, offs, axis=-1)


def _gather_rows(a, idx):
    return jax.vmap(lambda ab, ib: ab[ib])(a, idx)


def _indexer_scores(qi, ki, wi):
    s = jnp.einsum('bqhd,bsd->bqhs', qi, ki).astype(jnp.float32) * (IDX_DIM ** -0.5)
    return jnp.einsum('bqhs,bqh->bqs', jax.nn.relu(s), wi.astype(jnp.float32)) * (IDX_HEADS ** -0.5)


def _sparse_attend(q, k_sel, v_sel, valid):
    B, T = q.shape[:2]
    qg = q.reshape(B, T, N_KV_HEADS, N_HEADS // N_KV_HEADS, HEAD_DIM)
    s = jnp.einsum('btngd,btsnd->btngs', qg, k_sel).astype(jnp.float32) * (HEAD_DIM ** -0.5)
    s = jnp.where(valid[:, :, None, None, :], s, NEG)
    pr = jax.nn.softmax(s, axis=-1).astype(v_sel.dtype)
    o = jnp.einsum('btngs,btsnd->btngd', pr, v_sel)
    return o.reshape(B, T, D_B)


def _dsa_prompt(q, k, v, qi, ki, wi):
    B, T = q.shape[:2]
    topk = min(TOPK_MAX, T // 4)
    nb = T // Q_BLOCK
    key_pos = jnp.arange(T)

    def blk(xs):
        qb, qib, wib, qpos = xs
        scores = _indexer_scores(qib, ki, wib)
        scores = jnp.where(key_pos[None, None, :] <= qpos[None, :, None], scores, NEG)
        _, idx = lax.top_k(scores, topk)
        valid = idx <= qpos[None, :, None]
        return _sparse_attend(qb, _gather_rows(k, idx), _gather_rows(v, idx), valid)

    def to_blocks(a):
        return a.reshape(B, nb, Q_BLOCK, *a.shape[2:]).swapaxes(0, 1)

    out = lax.map(blk, (to_blocks(q), to_blocks(qi), to_blocks(wi), key_pos.reshape(nb, Q_BLOCK)))
    return out.swapaxes(0, 1).reshape(B, T, D_B)


def _dsa_sample(q, k, v, qi, ki, wi, ck, cv, cki, page_table):
    B, T = q.shape[:2]
    past_len = page_table.shape[1] * PAGE_SIZE
    L = past_len + T
    topk = min(TOPK_MAX, L // 4)
    ki_past = cki[page_table].reshape(B, past_len, IDX_DIM).astype(ki.dtype)
    ki_all = jnp.concatenate([ki_past, ki], axis=1)
    qpos = past_len + jnp.arange(T)
    scores = _indexer_scores(qi, ki_all, wi)
    scores = jnp.where(jnp.arange(L)[None, None, :] <= qpos[None, :, None], scores, NEG)
    _, idx = lax.top_k(scores, topk)
    valid = idx <= qpos[None, :, None]
    is_new = (idx >= past_len)[..., None, None]
    idx_past = jnp.minimum(idx, past_len - 1)
    rows = _gather_rows(page_table, idx_past // PAGE_SIZE) * PAGE_SIZE + idx_past % PAGE_SIZE
    idx_new = jnp.clip(idx - past_len, 0, T - 1)
    ck_flat = ck.reshape(-1, N_KV_HEADS, HEAD_DIM)
    cv_flat = cv.reshape(-1, N_KV_HEADS, HEAD_DIM)
    k_sel = jnp.where(is_new, _gather_rows(k, idx_new), ck_flat[rows].astype(k.dtype))
    v_sel = jnp.where(is_new, _gather_rows(v, idx_new), cv_flat[rows].astype(v.dtype))
    return _sparse_attend(q, k_sel, v_sel, valid)


def _conv_module(u, buf, w_dw, b_dw, ln_g, ln_b):
    full = jnp.concatenate([buf.astype(u.dtype), u], axis=1)
    y = lax.conv_general_dilated(full, w_dw[:, None, :].astype(full.dtype), window_strides=(1,),
                                 padding='VALID', dimension_numbers=('NWC', 'WIO', 'NWC'),
                                 feature_group_count=u.shape[-1])
    y = jax.nn.silu(_layernorm(y + b_dw, ln_g, ln_b))
    return y, full[:, -(CONV_W - 1):]


def _hgrn2(q, log_f, kk, i, S0):
    B, T, H, dk = q.shape
    dv = i.shape[-1]
    C = math.gcd(T, CHUNK)
    N = T // C

    def chunks(a):
        return a.astype(jnp.float32).reshape(B, N, C, H, a.shape[-1]).transpose(1, 0, 3, 2, 4)

    causal = jnp.tril(jnp.ones((C, C), dtype=bool))

    def step(S, xs):
        qc, lfc, kc, ic = xs
        b = jnp.cumsum(lfc, axis=2)
        inter = jnp.einsum('bhtd,bhdv->bhtv', qc * jnp.exp(b), S)
        diff = b[:, :, :, None, :] - b[:, :, None, :, :]
        decay = jnp.exp(jnp.where(causal[None, None, :, :, None], diff, NEG))
        att = jnp.einsum('bhtd,bhtsd,bhsd->bhts', qc, decay, kc)
        o = inter + jnp.einsum('bhts,bhsv->bhtv', att, ic)
        b_end = b[:, :, -1:, :]
        S_new = jnp.exp(b_end[:, :, 0, :])[..., None] * S + jnp.einsum(
            'bhsd,bhsv->bhdv', kc * jnp.exp(b_end - b), ic)
        return S_new, o

    S, o = lax.scan(step, S0.astype(jnp.float32), (chunks(q), chunks(log_f), chunks(kk), chunks(i)))
    o = o.transpose(1, 0, 3, 2, 4).reshape(B, T, H, dv)
    return o, S


def _layer(x, c, pos, p, lb, conv_buf, S0, attend):
    B, T, _ = x.shape
    mod = jax.nn.silu(c) @ p['w_ada'] + p['b_ada']
    shift, scale, gate = jnp.split(mod, 3, axis=-1)
    h = _rmsnorm(x, p['norm_g']) * (1 + scale[:, None, :]) + shift[:, None, :]
    (a_val, a_glu, a_gate, zq, zk, zv, zqi, zki, zwi, b_gate,
     cq, cf, ci, c_gate, g_a, g_b, g_c) = _split_in(h @ p['w_in'])

    u = a_val * jax.nn.sigmoid(a_glu)
    ya, new_buf = _conv_module(u, conv_buf, p['w_dw'], p['b_dw'], p['ln_g'], p['ln_b'])
    ya = ya * jax.nn.silu(a_gate)

    q = _rope(_rmsnorm(zq.reshape(B, T, N_HEADS, HEAD_DIM), p['q_norm_g']), pos)
    k = _rope(_rmsnorm(zk.reshape(B, T, N_KV_HEADS, HEAD_DIM), p['k_norm_g']), pos)
    v = zv.reshape(B, T, N_KV_HEADS, HEAD_DIM)
    qi = _rope(zqi.reshape(B, T, IDX_HEADS, IDX_DIM), pos)
    ki = _rope(_rmsnorm(zki)[:, :, None, :], pos)[:, :, 0, :]
    yb = attend(q, k, v, qi, ki, zwi) * jax.nn.silu(b_gate)

    fx = cf.reshape(B, T, C_HEADS, C_KDIM).astype(jnp.float32)
    log_f = jnp.logaddexp(jnp.log(jnp.maximum(lb, LB_FLOOR)), jnp.log1p(-lb) + jax.nn.log_sigmoid(fx))
    kk = (1.0 - lb) * jax.nn.sigmoid(-fx)
    qc = jax.nn.silu(cq).reshape(B, T, C_HEADS, C_KDIM)
    o, S_new = _hgrn2(qc, log_f, kk, ci.reshape(B, T, C_HEADS, C_VDIM), S0)
    yc = _rmsnorm(o, p['c_norm_g']).astype(x.dtype).reshape(B, T, D_C) * jax.nn.silu(c_gate)

    m = (jax.nn.sigmoid(g_a) * (ya @ p['w_proj_a'])
         + jax.nn.sigmoid(g_b) * (yb @ p['w_proj_b'])
         + jax.nn.sigmoid(g_c) * (yc @ p['w_proj_c']))
    y = x + gate[:, None, :] * (m @ p['w_out'])
    return y, k, v, ki, new_buf, S_new


def setup_inputs(seed: int = 0) -> dict:
    key = jax.random.key(seed)
    ks = jax.random.split(key, 32)
    n_pages = PAST_LEN // PAGE_SIZE
    n_pool = (DEC_BATCH * n_pages * 5) // 4

    def nrm(k, shape, s):
        return jax.random.normal(k, shape, jnp.float32) * s

    page_table = jax.random.permutation(ks[7], n_pool)[: DEC_BATCH * n_pages]
    page_table = page_table.reshape(DEC_BATCH, n_pages).astype(jnp.int32)
    return {
        'x_prompt': nrm(ks[0], (BATCH, SEQ, D_MODEL), 1.0),
        'x_sample': nrm(ks[1], (DEC_BATCH, DEC_SEQ, D_MODEL), 1.0),
        'cache_k': nrm(ks[2], (DEPTH, n_pool, PAGE_SIZE, N_KV_HEADS, HEAD_DIM), 1.0),
        'cache_v': nrm(ks[3], (DEPTH, n_pool, PAGE_SIZE, N_KV_HEADS, HEAD_DIM), 1.0),
        'cache_idx_k': nrm(ks[4], (DEPTH, n_pool, PAGE_SIZE, IDX_DIM), 1.0),
        'state_conv': nrm(ks[5], (DEPTH, DEC_BATCH, CONV_W - 1, D_A), 0.5),
        'state_hgrn': nrm(ks[6], (DEPTH, DEC_BATCH, C_HEADS, C_KDIM, C_VDIM), 0.5),
        'page_table': page_table,
        'c_prompt': nrm(ks[8], (BATCH, D_MODEL), 1.0),
        'c_sample': nrm(ks[9], (DEC_BATCH, D_MODEL), 1.0),
        'w_ada': nrm(ks[10], (DEPTH, D_MODEL, 3 * D_MODEL), 0.5 * D_MODEL ** -0.5),
        'b_ada': nrm(ks[11], (DEPTH, 3 * D_MODEL), 0.02),
        'norm_g': 1.0 + nrm(ks[12], (DEPTH, D_MODEL), 0.02),
        'w_in': nrm(ks[13], (DEPTH, D_MODEL, N_IN), D_MODEL ** -0.5),
        'w_dw': nrm(ks[14], (DEPTH, CONV_W, D_A), CONV_W ** -0.5),
        'b_dw': nrm(ks[15], (DEPTH, D_A), 0.02),
        'ln_g': 1.0 + nrm(ks[16], (DEPTH, D_A), 0.02),
        'ln_b': nrm(ks[17], (DEPTH, D_A), 0.02),
        'q_norm_g': 1.0 + nrm(ks[18], (DEPTH, HEAD_DIM), 0.02),
        'k_norm_g': 1.0 + nrm(ks[19], (DEPTH, HEAD_DIM), 0.02),
        'lb_logits': nrm(ks[20], (DEPTH, C_FDIM), 0.5),
        'c_norm_g': 1.0 + nrm(ks[21], (DEPTH, C_VDIM), 0.02),
        'w_proj_a': nrm(ks[22], (DEPTH, D_A, D_MODEL), D_A ** -0.5),
        'w_proj_b': nrm(ks[23], (DEPTH, D_B, D_MODEL), D_B ** -0.5),
        'w_proj_c': nrm(ks[24], (DEPTH, D_C, D_MODEL), D_C ** -0.5),
        'w_out': nrm(ks[25], (DEPTH, D_MODEL, D_MODEL), D_MODEL ** -0.5),
    }


def reference(x_prompt, x_sample, cache_k, cache_v, cache_idx_k, state_conv, state_hgrn, page_table,
              c_prompt, c_sample, w_ada, b_ada, norm_g, w_in, w_dw, b_dw, ln_g, ln_b, q_norm_g, k_norm_g,
              lb_logits, c_norm_g, w_proj_a, w_proj_b, w_proj_c, w_out):
    lbp = jax.nn.softmax(lb_logits.astype(jnp.float32), axis=0)
    lb_all = jnp.cumsum(lbp, axis=0) - lbp[0:1]
    Bp, Tp = x_prompt.shape[:2]
    pos_p = jnp.arange(Tp)
    pos_s = page_table.shape[1] * PAGE_SIZE + jnp.arange(x_sample.shape[1])
    buf0 = jnp.zeros((Bp, CONV_W - 1, D_A), x_prompt.dtype)
    S00 = jnp.zeros((Bp, C_HEADS, C_KDIM, C_VDIM), jnp.float32)

    xp, xs = x_prompt, x_sample
    kp_l, vp_l, kip_l, bp_l, sp_l = [], [], [], [], []
    ks_l, vs_l, kis_l, bs_l, ss_l = [], [], [], [], []
    for l in range(DEPTH):
        p = {'w_ada': w_ada[l], 'b_ada': b_ada[l], 'norm_g': norm_g[l], 'w_in': w_in[l],
             'w_dw': w_dw[l], 'b_dw': b_dw[l], 'ln_g': ln_g[l], 'ln_b': ln_b[l],
             'q_norm_g': q_norm_g[l], 'k_norm_g': k_norm_g[l], 'c_norm_g': c_norm_g[l],
             'w_proj_a': w_proj_a[l], 'w_proj_b': w_proj_b[l], 'w_proj_c': w_proj_c[l], 'w_out': w_out[l]}
        lb = lb_all[l].reshape(C_HEADS, C_KDIM)

        xp, kp, vp, kip, bp, sp = _layer(xp, c_prompt, pos_p, p, lb, buf0, S00, _dsa_prompt)

        def attend_s(q, k, v, qi, ki, wi, l=l):
            return _dsa_sample(q, k, v, qi, ki, wi, cache_k[l], cache_v[l], cache_idx_k[l], page_table)

        xs, ksm, vsm, kism, bsm, ssm = _layer(xs, c_sample, pos_s, p, lb, state_conv[l], state_hgrn[l], attend_s)

        kp_l.append(kp); vp_l.append(vp); kip_l.append(kip); bp_l.append(bp); sp_l.append(sp.astype(x_prompt.dtype))
        ks_l.append(ksm); vs_l.append(vsm); kis_l.append(kism); bs_l.append(bsm); ss_l.append(ssm.astype(state_hgrn.dtype))

    k_prompt = jnp.stack(kp_l)
    v_prompt = jnp.stack(vp_l)
    idxk_prompt = jnp.stack(kip_l)
    conv_prompt = jnp.stack(bp_l)
    hgrn_prompt = jnp.stack(sp_l)
    k_sample = jnp.stack(ks_l)
    v_sample = jnp.stack(vs_l)
    idxk_sample = jnp.stack(kis_l)
    conv_sample = jnp.stack(bs_l)
    hgrn_sample = jnp.stack(ss_l)
    return (xp, xs, k_prompt, v_prompt, idxk_prompt, conv_prompt, hgrn_prompt,
            k_sample, v_sample, idxk_sample, conv_sample, hgrn_sample)
```

```cpp
#include <hip/hip_runtime.h>
#include <cstdio>
#include <cstdint>
#include <cmath>

constexpr int D_MODEL = 1024, BATCH = 8, SEQ = 2048, DEPTH = 2, DEC_BATCH = 32, DEC_SEQ = 4, PAST_LEN = 8192, PAGE = 128;
constexpr int D_A = 512, CONV_W = 31, N_HEADS = 8, N_KV = 2, HD = 64, D_B = 512, KV_DIM = 128, IDX_HEADS = 4, IDX_DIM = 64, TOPK = 256;
constexpr int C_HEADS = 4, C_KDIM = 128, C_VDIM = 128, D_C = 512, C_FDIM = 512;
constexpr int N_IN = 8260;
constexpr int N_PAGES = PAST_LEN / PAGE;
constexpr int N_POOL = (DEC_BATCH * N_PAGES * 5) / 4;
constexpr int RP = BATCH * SEQ;
constexpr int RS = DEC_BATCH * DEC_SEQ;
constexpr int R = RP + RS;
constexpr float EPS = 1e-6f;
constexpr int Z_AVAL = 0, Z_AGLU = 512, Z_AGATE = 1024, Z_Q = 1536, Z_K = 2048, Z_V = 2176, Z_QI = 2304, Z_KI = 2560, Z_WI = 2624, Z_BGATE = 2628,
              Z_CQ = 3140, Z_CF = 3652, Z_CI = 4164, Z_CGATE = 4676, Z_GA = 5188, Z_GB = 6212, Z_GC = 7236;
static_assert(Z_GC + 1024 == N_IN, "splits");
constexpr size_t O_YP = 0, O_YS = O_YP + (size_t)RP * D_MODEL, O_KP = O_YS + (size_t)RS * D_MODEL, O_VP = O_KP + (size_t)DEPTH * RP * KV_DIM,
                 O_IKP = O_VP + (size_t)DEPTH * RP * KV_DIM, O_CVP = O_IKP + (size_t)DEPTH * RP * IDX_DIM, O_HGP = O_CVP + (size_t)DEPTH * BATCH * 30 * D_A,
                 O_KS = O_HGP + (size_t)DEPTH * BATCH * C_HEADS * C_KDIM * C_VDIM, O_VS = O_KS + (size_t)DEPTH * RS * KV_DIM, O_IKS = O_VS + (size_t)DEPTH * RS * KV_DIM,
                 O_CVS = O_IKS + (size_t)DEPTH * RS * IDX_DIM, O_HGS = O_CVS + (size_t)DEPTH * DEC_BATCH * 30 * D_A,
                 O_END = O_HGS + (size_t)DEPTH * DEC_BATCH * C_HEADS * C_KDIM * C_VDIM;

constexpr size_t MiB = 1u << 20;
constexpr size_t WS_CTL = 0, CTL_ZERO_BYTES = 64 * 1024;
constexpr size_t WS_MOD = 1 * MiB;
constexpr size_t WS_ROPE = 2 * MiB;
constexpr size_t WS_LB = 3 * MiB;
constexpr int RPAD = 16640, NPAD = 8448;
constexpr size_t WS_WTIN = 4 * MiB;
constexpr size_t WS_WTPA = 37 * MiB, WS_WTPB = 39 * MiB, WS_WTPC = 41 * MiB;
constexpr size_t WS_WTOUT = 43 * MiB;
constexpr size_t WS_H = 48 * MiB;
constexpr size_t WS_ACT = 81 * MiB;
constexpr size_t B512 = (size_t)RPAD * 512 * 2;
constexpr size_t A_U = WS_ACT, A_AG = A_U + B512, A_Q = A_AG + B512, A_BG = A_Q + B512, A_CQ = A_BG + B512, A_KK = A_CQ + B512, A_CI = A_KK + B512, A_CG = A_CI + B512,
                 A_LF = A_CG + B512  , A_K = A_LF + 2 * B512, A_V = A_K + B512 / 4, A_QI = A_V + B512 / 4, A_KI = A_QI + B512 / 2, A_WI = A_KI + B512 / 8  ,
                 A_GA = A_WI + (size_t)RPAD * 16, A_GB = A_GA + 2 * B512, A_GC = A_GB + 2 * B512,
                 A_YA = A_GC + 2 * B512, A_YB = A_YA + B512, A_YC = A_YB + B512  , A_MT = A_YC + B512  ,
                 A_M = A_MT + 4 * B512  , A_Y0 = A_M + 2 * B512, A_SELM = A_Y0 + (size_t)R * 1024 * 4  , A_VT = A_SELM + (size_t)RP * 64 * 4  ,
                 A_END = A_VT + (size_t)BATCH * 2 * 64 * SEQ * 2;
constexpr size_t WS_NEED = A_END;
static_assert(WS_WTIN + (size_t)2 * NPAD * 1024 * 2 <= WS_WTPA && WS_H + (size_t)RPAD * 1024 * 2 <= WS_ACT && A_END < 1200 * MiB, "ws map");

constexpr int LDS_BYTES = 147456;
constexpr int NT = 512;
#define LAS __attribute__((address_space(3)))

#define XB_TMO      128
#define XB_XCNT(j)  (256  + 64 * (j))
#define XB_XSUB(j)  (1280 + 64 * (j))
#define XB_XGEN(j)  (2304 + 64 * (j))
#define XB_TOP      3328
#define XB_TOPGEN   3392
#define XCD_BAR_WORDS 3456
#define XB_SPIN_CAP (1u << 22)
__device__ __forceinline__ unsigned xb_ld(unsigned* p)              { return __hip_atomic_load(p, __ATOMIC_RELAXED, __HIP_MEMORY_SCOPE_AGENT); }
__device__ __forceinline__ unsigned xb_add(unsigned* p, unsigned v) { return __hip_atomic_fetch_add(p, v, __ATOMIC_RELAXED, __HIP_MEMORY_SCOPE_AGENT); }
__device__ __forceinline__ unsigned xb_xcc_id() { return (unsigned)__builtin_amdgcn_s_getreg((3 << 11) | 20) & 0xFu; }
#define XB_SPIN(cond, bar) do { unsigned _sp = 0; while (cond) { __builtin_amdgcn_s_sleep(1); \
    if ((++_sp & 255u) == 0u) { if (xb_ld(&(bar)[XB_TMO])) break; if (_sp > XB_SPIN_CAP) { atomicAdd(&(bar)[XB_TMO], 1u); break; } } } } while (0)
struct XcdBarrier { unsigned* bar; unsigned x; volatile LAS unsigned* st; };
__device__ __forceinline__ XcdBarrier xcd_barrier_post(unsigned* bar, volatile LAS unsigned* st, int tid) {
    XcdBarrier b; b.bar = bar; b.x = xb_xcc_id(); b.st = st;
    if (tid == 0) (void)xb_add(&bar[XB_XCNT(b.x)], 1u);
    return b;
}
__device__ __forceinline__ void xcd_barrier_complete(unsigned* bar, unsigned x, unsigned& nloc, unsigned& nx) {
    const unsigned G = gridDim.x * gridDim.y * gridDim.z;
    unsigned sum, cnt, mine, sp = 0u;
    for (;;) {
        sum = 0u; cnt = 0u; mine = 0u;
#pragma unroll
        for (unsigned j = 0; j < 16; ++j) { const unsigned c = xb_ld(&bar[XB_XCNT(j)]); sum += c; cnt += (c > 0u) ? 1u : 0u; mine = (j == x) ? c : mine; }
        if (sum == G) break;
        __builtin_amdgcn_s_sleep(1);
        if ((++sp & 255u) == 0u) { if (xb_ld(&bar[XB_TMO])) break; if (sp > XB_SPIN_CAP) { atomicAdd(&bar[XB_TMO], 1u); break; } }
    }
    nloc = mine > 0u ? mine : 1u; nx = cnt > 0u ? cnt : 1u;
}
__device__ __forceinline__ void xcd_barrier(const XcdBarrier& b, int tid) {
    asm volatile("s_waitcnt vmcnt(0)" ::: "memory");
    __syncthreads();
    if (tid == 0) {
        unsigned* bar = b.bar;
        __builtin_amdgcn_s_waitcnt(0);
        unsigned nloc = b.st[0], nx = b.st[1];
        if (nloc == 0u) { xcd_barrier_complete(bar, b.x, nloc, nx); b.st[0] = nloc; b.st[1] = nx; }
        const unsigned old = xb_add(&bar[XB_XSUB(b.x)], 1u);
        const unsigned gen = old / nloc;
        if (old + 1u == (gen + 1u) * nloc) {
            __builtin_amdgcn_fence(__ATOMIC_RELEASE, "agent");
            asm volatile("s_waitcnt vmcnt(0)" ::: "memory");
            const unsigned og = xb_add(&bar[XB_TOP], 1u);
            const unsigned tg = og / nx;
            if (og + 1u == (tg + 1u) * nx) xb_add(&bar[XB_TOPGEN], 1u);
            else XB_SPIN(xb_ld(&bar[XB_TOPGEN]) == tg, bar);
            __builtin_amdgcn_fence(__ATOMIC_ACQUIRE, "agent");
            xb_add(&bar[XB_XGEN(b.x)], 1u);
            asm volatile("s_waitcnt vmcnt(0)" ::: "memory");
        } else {
            XB_SPIN(xb_ld(&bar[XB_XGEN(b.x)]) == gen, bar);
            __builtin_amdgcn_fence(__ATOMIC_ACQUIRE, "agent");
            asm volatile("s_waitcnt vmcnt(0)" ::: "memory");
        }
    }
    __syncthreads();
}

namespace pg8 {
#define PG8_LAS __attribute__((address_space(3)))
typedef unsigned short bf16_t;
typedef short bf16x8 __attribute__((ext_vector_type(8)));
typedef float f32x4 __attribute__((ext_vector_type(4)));
typedef unsigned u32x4 __attribute__((ext_vector_type(4)));
constexpr int BM = 256, BK = 64, HALF = 128, HTB = HALF * BK * 2  , STAGE_BYTES = 8 * HTB, NXCD = 8, WGM = 8;

__host__ __device__ __forceinline__ int lds_byte(int r, int c) { const int st = (r >> 4) * 2 + (c >> 5), rr = r & 15, cc = c & 31, ob = rr * 64 + cc * 2; return st * 1024 + (ob ^ (((ob >> 9) & 1) << 5)); }
__host__ __device__ __forceinline__ void stage_rc(int b, int& R, int& C) { const int st = b / 1024, sb = b % 1024, swz = sb ^ (((sb >> 9) & 1) << 5); R = (st >> 1) * 16 + swz / 64; C = (st & 1) * 32 + (swz % 64) / 2; }
__host__ __device__ __forceinline__ int perm32(int rho) { const int n = rho >> 4, i = rho & 15; return 8 * (i >> 2) + 4 * n + (i & 3); }

struct Unit { int pm, pn, x; };
struct Gemm { const bf16_t* A; const bf16_t* Bt; int M, N, K; };

struct StaticOrder {
    int nM, nN, nwg, G, c;
    __host__ __device__ void init(int M, int N, int G_, int c_) { nM = M / BM; nN = N / BM; nwg = nM * nN; G = G_; c = c_; }
    __host__ __device__ bool next(int i, Unit& u) const {
        const long L = (long)i * G + c; if (L >= nwg) return false;
        int wgid = (int)L; { const int q = nwg / NXCD, r = nwg % NXCD, xcd = wgid % NXCD, off = wgid / NXCD; wgid = (xcd < r ? xcd * (q + 1) : r * (q + 1) + (xcd - r) * q) + off; }
        const int nig = WGM * nN, gid = wgid / nig, fm = gid * WGM, gsz = (nM - fm) < WGM ? (nM - fm) : WGM;
        u.pm = fm + ((wgid % nig) % gsz); u.pn = (wgid % nig) / gsz; u.x = 0; return true;
    }
    __device__ __forceinline__ const char* aptr(const Gemm& g, const Unit& u, size_t tstep) const { return (const char*)g.A + (size_t)u.pm * tstep; }
    __device__ __forceinline__ const char* bptr(const Gemm& g, const Unit& u, size_t tstep) const { return (const char*)g.Bt + (size_t)u.pn * tstep; }
    __device__ __forceinline__ void a_ready(const Unit&) const {}
    __device__ __forceinline__ void done(const Unit&, int) const {}
};
__device__ __forceinline__ unsigned cvt_pk_bf16(float lo, float hi) { unsigned r; asm volatile("v_cvt_pk_bf16_f32 %0, %1, %2" : "=v"(r) : "v"(lo), "v"(hi)); return r; }
typedef float f32x2 __attribute__((ext_vector_type(2)));
template <class Epi, class Sched, bool ALIGN_EPI = false, bool SP2 = false>
__device__ __forceinline__ void gemm_phase(PG8_LAS unsigned char* lds, const Gemm g, const Sched& S, const Epi& E, int tid_in) {
    int tid_ = tid_in; asm volatile("" : "+v"(tid_));
    const int tid = tid_, wid = __builtin_amdgcn_readfirstlane(tid >> 6), lane = tid & 63, wr = wid >> 2, wc = wid & 3, fr = lane & 15, fq = lane >> 4;
    const int K = g.K, nt = K / BK;
    unsigned voffA[2], voffB[2];
#pragma unroll
    for (int i = 0; i < 2; ++i) { int R, C; stage_rc(tid * 16 + i * 8192, R, C); const int Rb = Epi::PERM ? ((R & ~31) + perm32(R & 31)) : R;
        voffA[i] = (unsigned)(R * K + C) * 2u; voffB[i] = (unsigned)(Rb * K + C) * 2u; }
    const size_t kstep = (size_t)(BK * 2);
    const size_t hstep = (size_t)HALF * K * 2;
    const size_t tstep = 2 * hstep;
    const unsigned ldsw = (unsigned)wid * 1024u;
    const int aoff = lds_byte(wr * 64 + fr, fq * 8), boff = lds_byte(wc * 32 + fr, fq * 8);
#define PG8_SA(b, h) (((b) * 2 + (h)) * HTB)
#define PG8_SB(b, h) ((4 + (b) * 2 + (h)) * HTB)
#define PG8_STAGE(bufoff, gbase, voff) do { _Pragma("unroll") for (int _i = 0; _i < 2; ++_i) \
        __builtin_amdgcn_global_load_lds((const unsigned*)((const char*)(gbase) + (voff)[_i]), (PG8_LAS unsigned*)(lds + (bufoff) + ldsw + _i * 8192), 16, 0, 0); } while (0)
#define PG8_LDA(dst, b, h) do { _Pragma("unroll") for (int m = 0; m < 4; ++m) _Pragma("unroll") for (int k = 0; k < 2; ++k) dst[m][k] = *(const PG8_LAS bf16x8*)(lds + PG8_SA(b, h) + aoff + m * 2048 + k * 1024); } while (0)
#define PG8_LDB(dst, b, h) do { _Pragma("unroll") for (int n = 0; n < 2; ++n) _Pragma("unroll") for (int k = 0; k < 2; ++k) dst[n][k] = *(const PG8_LAS bf16x8*)(lds + PG8_SB(b, h) + boff + n * 2048 + k * 1024); } while (0)
#define PG8_MMA(ai, bj, At, Bt) do { __builtin_amdgcn_s_setprio(1); _Pragma("unroll") for (int m = 0; m < 4; ++m) _Pragma("unroll") for (int n = 0; n < 2; ++n) _Pragma("unroll") for (int k = 0; k < 2; ++k) \
        acc[ai][bj][m][n] = __builtin_amdgcn_mfma_f32_16x16x32_bf16(Bt[n][k], At[m][k], acc[ai][bj][m][n], 0, 0, 0); __builtin_amdgcn_s_setprio(0); } while (0)
#define PG8_WAIT_V(n) asm volatile("s_waitcnt vmcnt(" #n ")" ::: "memory")
#define PG8_WAIT_L(n) asm volatile("s_waitcnt lgkmcnt(" #n ")" ::: "memory")
#define PG8_BAR __builtin_amdgcn_s_barrier()
#define PG8_SCHED __builtin_amdgcn_sched_barrier(0)
    Unit cur, nxt; int ui = 0;
    if (!S.next(0, cur)) return;
    f32x4 acc[2][2][4][2];
#pragma unroll
    for (int a = 0; a < 2; ++a)
#pragma unroll
        for (int b = 0; b < 2; ++b)
#pragma unroll
            for (int m = 0; m < 4; ++m)
#pragma unroll
                for (int n = 0; n < 2; ++n) acc[a][b][m][n] = (f32x4){0.f, 0.f, 0.f, 0.f};
    bf16x8 At[4][2], B0[2][2], B1[2][2];
    const char* cA = S.aptr(g, cur, tstep); const char* cB = S.bptr(g, cur, tstep);
    S.a_ready(cur);
    if constexpr (SP2) {
        PG8_STAGE(PG8_SB(0, 0), cB, voffB); PG8_STAGE(PG8_SB(0, 1), cB + hstep, voffB); PG8_STAGE(PG8_SA(0, 0), cA, voffA); PG8_STAGE(PG8_SA(0, 1), cA + hstep, voffA);
        if (wr == 1) PG8_BAR;
        PG8_WAIT_V(2); PG8_BAR;
        PG8_STAGE(PG8_SB(1, 0), cB + kstep, voffB); PG8_STAGE(PG8_SA(1, 0), cA + kstep, voffA); PG8_STAGE(PG8_SB(1, 1), cB + hstep + kstep, voffB);
        PG8_WAIT_V(6); PG8_BAR;
    } else {
        PG8_STAGE(PG8_SB(0, 0), cB, voffB); PG8_STAGE(PG8_SA(0, 0), cA, voffA); PG8_STAGE(PG8_SB(0, 1), cB + hstep, voffB); PG8_STAGE(PG8_SA(0, 1), cA + hstep, voffA);
        if (wr == 1) PG8_BAR;
        PG8_WAIT_V(4); PG8_BAR;
        PG8_STAGE(PG8_SB(1, 0), cB + kstep, voffB); PG8_STAGE(PG8_SA(1, 0), cA + kstep, voffA); PG8_STAGE(PG8_SB(1, 1), cB + hstep + kstep, voffB);
        PG8_WAIT_V(6); PG8_BAR;
    }
    for (;;) {
        const bool has_next = S.next(ui + 1, nxt);
        const char* nA = has_next ? S.aptr(g, nxt, tstep) : cA; const char* nB = has_next ? S.bptr(g, nxt, tstep) : cB;
        for (int t = 0; t < nt; t += 2) {
            const bool last = (t == nt - 2);
            const char* a1 = cA + (size_t)(t + 1) * kstep;
            const char* a2 = last ? nA : cA + (size_t)(t + 2) * kstep; const char* b2 = last ? nB : cB + (size_t)(t + 2) * kstep;
            const char* a3 = a2 + kstep; const char* b3 = b2 + kstep;
            if (last && has_next) S.a_ready(nxt);
            if constexpr (SP2) {
            PG8_LDB(B0, 0, 0); PG8_LDB(B1, 0, 1); PG8_SCHED; PG8_LDA(At, 0, 0); PG8_STAGE(PG8_SA(1, 1), a1 + hstep, voffA);
            PG8_WAIT_V(8); PG8_WAIT_L(0); PG8_BAR; PG8_MMA(0, 0, At, B0); PG8_MMA(0, 1, At, B1); PG8_BAR; PG8_SCHED;
            PG8_LDA(At, 0, 1); PG8_STAGE(PG8_SB(0, 0), b2, voffB); PG8_STAGE(PG8_SB(0, 1), b2 + hstep, voffB); PG8_STAGE(PG8_SA(0, 0), a2, voffA);
            PG8_WAIT_V(8); PG8_WAIT_L(0); PG8_BAR; PG8_MMA(1, 0, At, B0); PG8_MMA(1, 1, At, B1); PG8_BAR; PG8_SCHED;
            PG8_LDB(B0, 1, 0); PG8_LDB(B1, 1, 1); PG8_SCHED; PG8_LDA(At, 1, 0); PG8_STAGE(PG8_SA(0, 1), a2 + hstep, voffA);
            PG8_WAIT_V(8); PG8_WAIT_L(0); PG8_BAR; PG8_MMA(0, 0, At, B0); PG8_MMA(0, 1, At, B1); PG8_BAR; PG8_SCHED;
            PG8_LDA(At, 1, 1); PG8_STAGE(PG8_SB(1, 0), b3, voffB); PG8_STAGE(PG8_SB(1, 1), b3 + hstep, voffB); PG8_STAGE(PG8_SA(1, 0), a3, voffA);
            PG8_WAIT_V(8); PG8_WAIT_L(0); PG8_BAR; PG8_MMA(1, 0, At, B0); PG8_MMA(1, 1, At, B1); PG8_BAR; PG8_SCHED;
            } else {
            PG8_LDB(B0, 0, 0); PG8_SCHED; PG8_LDA(At, 0, 0); PG8_STAGE(PG8_SA(1, 1), a1 + hstep, voffA);
            PG8_WAIT_L(8); PG8_BAR; PG8_WAIT_L(0); PG8_MMA(0, 0, At, B0); PG8_BAR; PG8_SCHED;
            PG8_LDB(B1, 0, 1); PG8_STAGE(PG8_SB(0, 0), b2, voffB);
            PG8_BAR; PG8_WAIT_L(0); PG8_MMA(0, 1, At, B1); PG8_BAR;
            PG8_LDA(At, 0, 1); PG8_STAGE(PG8_SA(0, 0), a2, voffA);
            PG8_BAR; PG8_WAIT_L(0); PG8_MMA(1, 0, At, B0); PG8_BAR; PG8_SCHED;
            PG8_STAGE(PG8_SB(0, 1), b2 + hstep, voffB);
            PG8_WAIT_V(6); PG8_BAR; PG8_MMA(1, 1, At, B1); PG8_BAR;
            PG8_LDB(B0, 1, 0); PG8_SCHED; PG8_LDA(At, 1, 0); PG8_STAGE(PG8_SA(0, 1), a2 + hstep, voffA);
            PG8_WAIT_L(8); PG8_BAR; PG8_WAIT_L(0); PG8_MMA(0, 0, At, B0); PG8_BAR; PG8_SCHED;
            PG8_LDB(B1, 1, 1); PG8_STAGE(PG8_SB(1, 0), b3, voffB);
            PG8_BAR; PG8_WAIT_L(0); PG8_MMA(0, 1, At, B1); PG8_BAR;
            PG8_LDA(At, 1, 1); PG8_STAGE(PG8_SA(1, 0), a3, voffA);
            PG8_BAR; PG8_WAIT_L(0); PG8_MMA(1, 0, At, B0); PG8_BAR; PG8_SCHED;
            PG8_STAGE(PG8_SB(1, 1), b3 + hstep, voffB);
            PG8_WAIT_V(6); PG8_BAR; PG8_MMA(1, 1, At, B1); PG8_BAR;
            }
        }
        if constexpr (ALIGN_EPI) { if (wr == 0) PG8_BAR; }
        if constexpr (!Epi::AFTER_DRAIN) { E(acc, cur, wr, wc, fr, fq); S.done(cur, ui); }
        if (!has_next) break;
#pragma unroll
        for (int a = 0; a < 2; ++a)
#pragma unroll
            for (int b = 0; b < 2; ++b)
#pragma unroll
                for (int m = 0; m < 4; ++m)
#pragma unroll
                    for (int n = 0; n < 2; ++n) acc[a][b][m][n] = (f32x4){0.f, 0.f, 0.f, 0.f};
        cur = nxt; cA = nA; cB = nB; ++ui;
        if constexpr (ALIGN_EPI) { if (wr == 1) PG8_BAR; }
    }
    PG8_WAIT_V(0);
    if constexpr (!ALIGN_EPI) { if (wr == 0) PG8_BAR; }
    PG8_BAR;
    if constexpr (Epi::AFTER_DRAIN) { E.fused(acc, cur, wr, wc, fr, fq, lds, wid, lane); S.done(cur, ui); }
#undef PG8_SA
#undef PG8_SB
#undef PG8_STAGE
#undef PG8_LDA
#undef PG8_LDB
#undef PG8_MMA
#undef PG8_WAIT_V
#undef PG8_WAIT_L
#undef PG8_BAR
#undef PG8_SCHED
}
}

struct Args {
    const float* x_prompt; const float* x_sample; const float* cache_k; const float* cache_v; const float* cache_idx_k; const float* state_conv; const float* state_hgrn;
    const int* page_table; const float* c_prompt; const float* c_sample; const float* w_ada; const float* b_ada; const float* norm_g; const float* w_in; const float* w_dw;
    const float* b_dw; const float* ln_g; const float* ln_b; const float* q_norm_g; const float* k_norm_g; const float* lb_logits; const float* c_norm_g;
    const float* w_proj_a; const float* w_proj_b; const float* w_proj_c; const float* w_out;
    float* out; unsigned char* ws; int ph_lo, ph_hi, use_bar, pad;
};
typedef const Args __attribute__((address_space(4)))* KA;
struct Ctx {
    int tid, lane, wave, bid, nblk;
    unsigned char* lds;
    LAS unsigned char* lds_las;
};

__device__ __forceinline__ float silu_f(float x) { return x / (1.f + __expf(-x)); }
__device__ __forceinline__ float sigmoid_f(float x) { return 1.f / (1.f + __expf(-x)); }
__device__ __forceinline__ float fsig(float x) { return __builtin_amdgcn_rcpf(1.f + __expf(-x)); }
typedef unsigned short bf16_t;
typedef float f32x4 __attribute__((ext_vector_type(4)));
typedef unsigned u32x4 __attribute__((ext_vector_type(4)));
typedef short bf16x8_t __attribute__((ext_vector_type(8)));
typedef unsigned u32x2 __attribute__((ext_vector_type(2)));
__device__ __forceinline__ float bf2f(bf16_t v) { return __uint_as_float((unsigned)v << 16); }
__device__ __forceinline__ float LD(const bf16_t* p, size_t i) { return bf2f(p[i]); }
__device__ __forceinline__ unsigned f2bf(float f) { unsigned u = __float_as_uint(f); return (u + 0x7fffu + ((u >> 16) & 1u)) >> 16; }
__device__ __forceinline__ unsigned pk2(float lo, float hi) { return f2bf(lo) | (f2bf(hi) << 16); }
__device__ __forceinline__ void ld8(const bf16_t* p, float (&o)[8]) { const u32x4 w = *(const u32x4*)p;
    o[0] = __uint_as_float(w.x << 16); o[1] = __uint_as_float(w.x & 0xffff0000u); o[2] = __uint_as_float(w.y << 16); o[3] = __uint_as_float(w.y & 0xffff0000u);
    o[4] = __uint_as_float(w.z << 16); o[5] = __uint_as_float(w.z & 0xffff0000u); o[6] = __uint_as_float(w.w << 16); o[7] = __uint_as_float(w.w & 0xffff0000u); }
__device__ __forceinline__ void ld8(const float* p, float (&o)[8]) { const float4 a = *(const float4*)p, b = *(const float4*)(p + 4); o[0] = a.x; o[1] = a.y; o[2] = a.z; o[3] = a.w; o[4] = b.x; o[5] = b.y; o[6] = b.z; o[7] = b.w; }
__device__ __forceinline__ void unpack8(const u32x4& w, f32x4& lo, f32x4& hi) {
    lo = (f32x4){__uint_as_float(w.x << 16), __uint_as_float(w.x & 0xffff0000u), __uint_as_float(w.y << 16), __uint_as_float(w.y & 0xffff0000u)};
    hi = (f32x4){__uint_as_float(w.z << 16), __uint_as_float(w.z & 0xffff0000u), __uint_as_float(w.w << 16), __uint_as_float(w.w & 0xffff0000u)}; }
__device__ __forceinline__ float wave_sum(float v) {
#pragma unroll
    for (int o = 1; o < 64; o <<= 1) v += __shfl_xor(v, o);
    return v;
}
__device__ __forceinline__ float wave_max(float v) {
#pragma unroll
    for (int o = 1; o < 64; o <<= 1) v = fmaxf(v, __shfl_xor(v, o));
    return v;
}
__device__ __forceinline__ float block_sum(const Ctx& c, float v, float* red) {
    v = wave_sum(v);
    __syncthreads();
    if (c.lane == 0) red[c.wave] = v;
    __syncthreads();
    float s = 0.f;
#pragma unroll
    for (int w = 0; w < NT / 64; ++w) s += red[w];
    return s;
}

__device__ __forceinline__ int rope_slot(int row) { return row < RP ? (row % SEQ) : (SEQ + ((row - RP) % DEC_SEQ)); }
__device__ __forceinline__ int mod_row(int row) { return row < RP ? (row / SEQ) : (BATCH + (row - RP) / DEC_SEQ); }

__device__ __forceinline__ int inproj_src(int n) {
    const int pn = n >> 8, c = n & 255, bj = c >> 7, wcol = (c >> 5) & 3, i = c & 31, x = c & 127;
    if (pn < 4) return (bj ? Z_AGLU : Z_AVAL) + 128 * pn + x;
    if (pn < 6) return Z_AGATE + 256 * (pn - 4) + c;
    if (pn < 8) return Z_Q + (4 * (pn - 6) + wcol) * 64 + 32 * bj + i;
    if (pn == 8) return (wcol < 2 ? Z_K + wcol * 64 : Z_V + (wcol - 2) * 64) + 32 * bj + i;
    if (pn == 9) return Z_QI + wcol * 64 + 32 * bj + i;
    if (pn == 10) { if (wcol == 0) return Z_KI + 32 * bj + i; if (wcol == 1 && bj == 0 && i < 4) return Z_WI + i; return -1; }
    if (pn < 13) return Z_BGATE + 256 * (pn - 11) + c;
    if (pn < 15) return Z_CQ + 256 * (pn - 13) + c;
    if (pn < 17) return Z_CF + 256 * (pn - 15) + c;
    if (pn < 19) return Z_CI + 256 * (pn - 17) + c;
    if (pn < 21) return Z_CGATE + 256 * (pn - 19) + c;
    if (pn < 25) return Z_GA + 256 * (pn - 21) + c;
    if (pn < 29) return Z_GB + 256 * (pn - 25) + c;
    return Z_GC + 256 * (pn - 29) + c;
}
constexpr int CW_PREQ = 12288;
template <bool PERMUTE>
__device__ __forceinline__ void transpose_item(const float* W, int K, int N, bf16_t* WT, int nrows, LAS bf16_t* T, int item, int lane) {
    const int nblk = nrows / 64, kb = item / nblk, nb = item % nblk, k0 = 64 * kb, n0 = 64 * nb;
    const int q = lane & 15, r = lane >> 4;
    const int sc = PERMUTE ? inproj_src(n0 + 4 * q) : n0 + 4 * q; const int scc = sc >= 0 ? sc : 0;
    f32x4 v[16];
#pragma unroll
    for (int i = 0; i < 16; ++i) { const int kk = 16 * (i >> 2) + 4 * r + (i & 3); v[i] = *(const f32x4*)(W + (size_t)(k0 + kk) * N + scc); }
    const float zm = sc >= 0 ? 1.f : 0.f;
#pragma unroll
    for (int j = 0; j < 4; ++j)
#pragma unroll
        for (int e = 0; e < 4; ++e) *(LAS u32x2*)(T + (4 * q + e) * 72 + 16 * j + 4 * r) = (u32x2){pk2(v[4 * j][e] * zm, v[4 * j + 1][e] * zm), pk2(v[4 * j + 2][e] * zm, v[4 * j + 3][e] * zm)};
    asm volatile("s_waitcnt lgkmcnt(0)" ::: "memory"); __builtin_amdgcn_wave_barrier();
    const int c = lane & 7;
#pragma unroll
    for (int jj = 0; jj < 8; ++jj) { const int n = (lane >> 3) + 8 * jj; const u32x4 o = *(const LAS u32x4*)(T + n * 72 + 8 * c); *(u32x4*)(WT + (size_t)(n0 + n) * K + k0 + 8 * c) = o; }
    asm volatile("s_waitcnt lgkmcnt(0)" ::: "memory"); __builtin_amdgcn_wave_barrier();
}
__device__ __forceinline__ void phase_pre(KA a, const Ctx& c) {
    float* mod = (float*)(a->ws + WS_MOD); float* rope = (float*)(a->ws + WS_ROPE); float* lbw = (float*)(a->ws + WS_LB);
    const int gtid = c.bid * NT + c.tid, gn = c.nblk * NT;
    {
        LAS float* RED = (LAS float*)c.lds_las;
        const int c16 = c.lane & 15, g = c.lane >> 4;
        for (int it = c.nblk - 1 - c.bid; it < DEPTH * 96; it += c.nblk) {
            const int l = it / 96, j0 = (it % 96) * 32;
            __syncthreads();
            for (int i = c.tid; i < 40 * 32; i += NT) RED[i] = 0.f;
            f32x4 acc[2][3];
#pragma unroll
            for (int jt = 0; jt < 2; ++jt)
#pragma unroll
                for (int rt = 0; rt < 3; ++rt) acc[jt][rt] = (f32x4){0.f, 0.f, 0.f, 0.f};
#pragma unroll 2
            for (int ks = 0; ks < 4; ++ks) {
                const int k0 = 128 * c.wave + 32 * ks + 8 * g;
                float wr[2][8]; f32x4 cr[3][2];
#pragma unroll
                for (int jt = 0; jt < 2; ++jt)
#pragma unroll
                    for (int jj = 0; jj < 8; ++jj) wr[jt][jj] = a->w_ada[((size_t)l * D_MODEL + k0 + jj) * 3072 + j0 + 16 * jt + c16];
#pragma unroll
                for (int rt = 0; rt < 3; ++rt) { const int r = 16 * rt + c16, rc = r < 40 ? r : 39;
                    const float* cp = (rc < BATCH ? a->c_prompt + (size_t)rc * D_MODEL : a->c_sample + (size_t)(rc - BATCH) * D_MODEL) + k0;
                    cr[rt][0] = *(const f32x4*)cp; cr[rt][1] = *(const f32x4*)(cp + 4); }
                bf16x8_t Ah[2], Al[2], Bh[3], Bl[3];
#pragma unroll
                for (int jt = 0; jt < 2; ++jt) { unsigned h[8], lo[8];
#pragma unroll
                    for (int jj = 0; jj < 8; ++jj) { h[jj] = f2bf(wr[jt][jj]); lo[jj] = f2bf(wr[jt][jj] - __uint_as_float(h[jj] << 16)); }
                    Ah[jt] = __builtin_bit_cast(bf16x8_t, (u32x4){h[0] | (h[1] << 16), h[2] | (h[3] << 16), h[4] | (h[5] << 16), h[6] | (h[7] << 16)});
                    Al[jt] = __builtin_bit_cast(bf16x8_t, (u32x4){lo[0] | (lo[1] << 16), lo[2] | (lo[3] << 16), lo[4] | (lo[5] << 16), lo[6] | (lo[7] << 16)}); }
#pragma unroll
                for (int rt = 0; rt < 3; ++rt) { unsigned h[8], lo[8]; const bool live = 16 * rt + c16 < 40;
#pragma unroll
                    for (int jj = 0; jj < 8; ++jj) { const float sv = live ? silu_f(cr[rt][jj >> 2][jj & 3]) : 0.f; h[jj] = f2bf(sv); lo[jj] = f2bf(sv - __uint_as_float(h[jj] << 16)); }
                    Bh[rt] = __builtin_bit_cast(bf16x8_t, (u32x4){h[0] | (h[1] << 16), h[2] | (h[3] << 16), h[4] | (h[5] << 16), h[6] | (h[7] << 16)});
                    Bl[rt] = __builtin_bit_cast(bf16x8_t, (u32x4){lo[0] | (lo[1] << 16), lo[2] | (lo[3] << 16), lo[4] | (lo[5] << 16), lo[6] | (lo[7] << 16)}); }
#pragma unroll
                for (int jt = 0; jt < 2; ++jt)
#pragma unroll
                    for (int rt = 0; rt < 3; ++rt) {
                        acc[jt][rt] = __builtin_amdgcn_mfma_f32_16x16x32_bf16(Al[jt], Bh[rt], acc[jt][rt], 0, 0, 0);
                        acc[jt][rt] = __builtin_amdgcn_mfma_f32_16x16x32_bf16(Ah[jt], Bl[rt], acc[jt][rt], 0, 0, 0);
                        acc[jt][rt] = __builtin_amdgcn_mfma_f32_16x16x32_bf16(Ah[jt], Bh[rt], acc[jt][rt], 0, 0, 0); }
            }
            __syncthreads();
#pragma unroll
            for (int jt = 0; jt < 2; ++jt)
#pragma unroll
                for (int rt = 0; rt < 3; ++rt) { const int r = 16 * rt + c16;
                    if (r < 40) {
#pragma unroll
                        for (int i = 0; i < 4; ++i) atomicAdd((float*)(RED + r * 32 + 16 * jt + 4 * g + i), acc[jt][rt][i]); } }
            __syncthreads();
            for (int i = c.tid; i < 40 * 32; i += NT) { const int r = i >> 5, jj = i & 31; mod[((size_t)l * 40 + r) * 3072 + j0 + jj] = RED[i] + a->b_ada[l * 3072 + j0 + jj]; }
        }
    }
    if (c.bid < 64) for (int i = gtid; i < 2052 * 32; i += 64 * NT) {
        const int j = i % 32, s = i / 32; const double pos = s < SEQ ? (double)s : (double)(PAST_LEN + s - SEQ);
        const double inv = pow(10000.0, -(double)j / 32.0);
        const double ang = pos * inv;
        rope[2 * i] = (float)cos(ang); rope[2 * i + 1] = (float)sin(ang);
    }
    for (int i = gtid; i < C_FDIM; i += gn) {
        const float l0 = a->lb_logits[i], l1 = a->lb_logits[C_FDIM + i]; const float mx = fmaxf(l0, l1);
        const float e0 = expf(l0 - mx), e1 = expf(l1 - mx);
        lbw[i] = 0.f; lbw[C_FDIM + i] = e1 / (e0 + e1);
    }
    __syncthreads();
    {
        LAS bf16_t* TB = (LAS bf16_t*)c.lds_las;
        LAS int* slot = (LAS int*)(c.lds_las + 2 * 36864);
        unsigned* ctr = (unsigned*)(a->ws + WS_CTL) + CW_PREQ;
        constexpr int I_IN = (1024 / 64) * (NPAD / 256), I_P = (512 / 64) * (1024 / 256), I_O = (1024 / 64) * (1024 / 256), PER_L = I_IN + 3 * I_P + I_O;
        constexpr int NITEMS = DEPTH * PER_L;
        const float* W; bf16_t* WT; int N, K, k0, n0, sc; bool perm;
#define PRE_DECODE(it_) do { int r_ = (it_); const int l_ = r_ / PER_L; r_ -= l_ * PER_L; int nblk_; \
            if (r_ < I_IN) { W = a->w_in + (size_t)l_ * 1024 * N_IN; N = N_IN; K = 1024; WT = (bf16_t*)(a->ws + WS_WTIN) + (size_t)l_ * NPAD * 1024; nblk_ = NPAD / 256; perm = true; } \
            else { r_ -= I_IN; nblk_ = 4; perm = false; N = 1024; \
                if (r_ < I_P) { W = a->w_proj_a + (size_t)l_ * 512 * 1024; K = 512; WT = (bf16_t*)(a->ws + WS_WTPA) + (size_t)l_ * 1024 * 512; } \
                else if (r_ < 2 * I_P) { r_ -= I_P; W = a->w_proj_b + (size_t)l_ * 512 * 1024; K = 512; WT = (bf16_t*)(a->ws + WS_WTPB) + (size_t)l_ * 1024 * 512; } \
                else if (r_ < 3 * I_P) { r_ -= 2 * I_P; W = a->w_proj_c + (size_t)l_ * 512 * 1024; K = 512; WT = (bf16_t*)(a->ws + WS_WTPC) + (size_t)l_ * 1024 * 512; } \
                else { r_ -= 3 * I_P; W = a->w_out + (size_t)l_ * 1024 * 1024; K = 1024; WT = (bf16_t*)(a->ws + WS_WTOUT) + (size_t)l_ * 1024 * 1024; } } \
            k0 = 64 * (r_ / nblk_); n0 = 256 * (r_ % nblk_); sc = perm ? inproj_src(n0 + 4 * c.lane) : n0 + 4 * c.lane; } while (0)
#define PRE_LOAD() do { const int scc_ = sc >= 0 ? sc : 0; _Pragma("unroll") for (int i = 0; i < 8; ++i) v[i] = *(const f32x4*)(W + (size_t)(k0 + 8 * c.wave + i) * N + scc_); zm = sc >= 0 ? 1.f : 0.f; } while (0)
        if (c.tid == 0) slot[0] = (int)__hip_atomic_fetch_add(ctr, 1u, __ATOMIC_RELAXED, __HIP_MEMORY_SCOPE_AGENT);
        __syncthreads();
        int it = slot[0], p = 0; f32x4 v[8]; float zm = 0.f;
        if (it < NITEMS) { PRE_DECODE(it); PRE_LOAD(); }
#pragma unroll 1
        while (it < NITEMS) {
            LAS bf16_t* T = TB + p * (256 * 72);
#pragma unroll
            for (int e = 0; e < 4; ++e) *(LAS u32x4*)(T + (4 * c.lane + e) * 72 + 8 * (c.wave ^ (c.lane & 7))) =
                (u32x4){pk2(v[0][e] * zm, v[1][e] * zm), pk2(v[2][e] * zm, v[3][e] * zm), pk2(v[4][e] * zm, v[5][e] * zm), pk2(v[6][e] * zm, v[7][e] * zm)};
            if (c.tid == 0) slot[p ^ 1] = (int)__hip_atomic_fetch_add(ctr, 1u, __ATOMIC_RELAXED, __HIP_MEMORY_SCOPE_AGENT);
            asm volatile("s_waitcnt lgkmcnt(0)" ::: "memory"); __syncthreads();
            const int nxt = slot[p ^ 1];
            bf16_t* dst = WT + (size_t)(n0 + 32 * c.wave + (c.lane >> 3)) * K + k0 + 8 * (c.lane & 7); const int dK = K;
            if (nxt < NITEMS) { PRE_DECODE(nxt); PRE_LOAD(); }
#pragma unroll
            for (int jj = 0; jj < 4; ++jj) { const int n_ = 32 * c.wave + (c.lane >> 3) + 8 * jj; const u32x4 o = *(const LAS u32x4*)(T + n_ * 72 + 8 * ((c.lane & 7) ^ ((n_ >> 2) & 7))); *(u32x4*)(dst + (size_t)(8 * jj) * dK) = o; }
            p ^= 1; it = nxt;
        }
#undef PRE_DECODE
#undef PRE_LOAD
    }
}

__device__ __forceinline__ void phase_norm(KA a, const Ctx& c, int l, const float* xin_p, const float* xin_s) {
    const float* mod = (const float*)(a->ws + WS_MOD) + (size_t)l * 40 * 3072; bf16_t* H = (bf16_t*)(a->ws + WS_H);
    const float* g = a->norm_g + l * D_MODEL;
    const bf16_t* xb16 = (const bf16_t*)(a->ws + A_Y0);
    const int gw = c.bid * (NT / 64) + c.wave, ngw = c.nblk * (NT / 64);
    int cur_mr = -1; float4 gs[4], shv[4];
#pragma unroll
    for (int j = 0; j < 4; ++j) { gs[j] = make_float4(0.f, 0.f, 0.f, 0.f); shv[j] = gs[j]; }
#define NORM_ROW(row_, v_) do { const int r_ = (row_); \
        unsigned long long* o8 = (unsigned long long*)(H + (size_t)r_ * D_MODEL) + c.lane; float ss = 0.f; \
        _Pragma("unroll") for (int j = 0; j < 4; ++j) ss += v_[j].x * v_[j].x + v_[j].y * v_[j].y + v_[j].z * v_[j].z + v_[j].w * v_[j].w; \
        ss = wave_sum(ss); const float rstd = rsqrtf(ss * (1.f / D_MODEL) + EPS); \
        const int mrow = mod_row(r_); \
        if (mrow != cur_mr) { cur_mr = mrow; const float* mr = mod + (size_t)mrow * 3072; \
            _Pragma("unroll") for (int j = 0; j < 4; ++j) { const int col = 4 * c.lane + 256 * j; \
                const float4 gg = *(const float4*)(g + col), sc = *(const float4*)(mr + 1024 + col); shv[j] = *(const float4*)(mr + col); \
                gs[j] = make_float4(gg.x * (1.f + sc.x), gg.y * (1.f + sc.y), gg.z * (1.f + sc.z), gg.w * (1.f + sc.w)); } } \
        _Pragma("unroll") for (int j = 0; j < 4; ++j) { \
            const float h0 = v_[j].x * rstd * gs[j].x + shv[j].x, h1 = v_[j].y * rstd * gs[j].y + shv[j].y, h2 = v_[j].z * rstd * gs[j].z + shv[j].z, h3 = v_[j].w * rstd * gs[j].w + shv[j].w; \
            o8[64 * j] = (unsigned long long)pk2(h0, h1) | ((unsigned long long)pk2(h2, h3) << 32); } } while (0)
#define NORM_UNPK(w2_) make_float4(__uint_as_float((w2_).x << 16), __uint_as_float((w2_).x & 0xffff0000u), __uint_as_float((w2_).y << 16), __uint_as_float((w2_).y & 0xffff0000u))
    if (c.nblk == 256) {
        const int rbase = (c.bid & 7) * SEQ + ((c.bid >> 3) * 8 + c.wave);
        if (l == 0) {
            float4 vv[8][4];
#pragma unroll
            for (int i = 0; i < 8; ++i)
#pragma unroll
                for (int j = 0; j < 4; ++j) vv[i][j] = *(const float4*)(xin_p + (size_t)(rbase + 256 * i) * D_MODEL + 4 * c.lane + 256 * j);
#pragma unroll
            for (int i = 0; i < 8; ++i) NORM_ROW(rbase + 256 * i, vv[i]);
        } else {
            u32x2 ww[8][4];
#pragma unroll
            for (int i = 0; i < 8; ++i)
#pragma unroll
                for (int j = 0; j < 4; ++j) ww[i][j] = *(const u32x2*)(xb16 + (size_t)(rbase + 256 * i) * D_MODEL + 4 * c.lane + 256 * j);
#pragma unroll
            for (int i = 0; i < 8; ++i) { float4 v[4];
#pragma unroll
                for (int j = 0; j < 4; ++j) v[j] = NORM_UNPK(ww[i][j]);
                NORM_ROW(rbase + 256 * i, v); }
        }
        if (gw < RPAD - RP) {
            const int row = RP + gw;
            if (row >= R) { unsigned long long* o8 = (unsigned long long*)(H + (size_t)row * D_MODEL) + c.lane;
#pragma unroll
                for (int j = 0; j < 4; ++j) o8[64 * j] = 0ull; }
            else { float4 v[4];
#pragma unroll
                for (int j = 0; j < 4; ++j) { if (l == 0) v[j] = *(const float4*)(xin_s + (size_t)(row - RP) * D_MODEL + 4 * c.lane + 256 * j);
                    else { const u32x2 w2 = *(const u32x2*)(xb16 + (size_t)row * D_MODEL + 4 * c.lane + 256 * j); v[j] = NORM_UNPK(w2); } }
                NORM_ROW(row, v); }
        }
    } else {
        for (int row = gw; row < RPAD; row += ngw) {
            if (row >= R) { unsigned long long* o8 = (unsigned long long*)(H + (size_t)row * D_MODEL) + c.lane;
#pragma unroll
                for (int j = 0; j < 4; ++j) o8[64 * j] = 0ull;
                continue; }
            float4 v[4];
#pragma unroll
            for (int j = 0; j < 4; ++j) { if (l == 0) { const float* xr = row < RP ? xin_p + (size_t)row * D_MODEL : xin_s + (size_t)(row - RP) * D_MODEL; v[j] = *(const float4*)(xr + 4 * c.lane + 256 * j); }
                else { const u32x2 w2 = *(const u32x2*)(xb16 + (size_t)row * D_MODEL + 4 * c.lane + 256 * j); v[j] = NORM_UNPK(w2); } }
            NORM_ROW(row, v);
        }
    }
#undef NORM_ROW
#undef NORM_UNPK
}

struct EpiIn {
    static constexpr bool PERM = true, AFTER_DRAIN = false;
    KA a; int l;
    __device__ __forceinline__ static u32x4 pack8(const f32x4& v0, const f32x4& v1) { u32x4 w; w.x = pg8::cvt_pk_bf16(v0[0], v0[1]); w.y = pg8::cvt_pk_bf16(v0[2], v0[3]); w.z = pg8::cvt_pk_bf16(v1[0], v1[1]); w.w = pg8::cvt_pk_bf16(v1[2], v1[3]); return w; }
    __device__ __forceinline__ void operator()(const f32x4 (&acc)[2][2][4][2], const pg8::Unit& u, int wr, int wc, int fr, int fq) const {
        asm volatile("" : "+v"(fr), "+v"(fq));
        unsigned char* ws = a->ws; float* out = a->out;
        const int pn = u.pn, rbase = u.pm * 256 + wr * 64 + fr, cl = wc * 32 + 8 * fq;
        if (pn < 4) {
            bf16_t* U = (bf16_t*)(ws + A_U);
#pragma unroll
            for (int ai = 0; ai < 2; ++ai)
#pragma unroll
                for (int m = 0; m < 4; ++m) { int row = rbase + ai * 128 + m * 16; asm volatile("" : "+v"(row));     f32x4 uu[2];
#pragma unroll
                    for (int n = 0; n < 2; ++n)
#pragma unroll
                        for (int j = 0; j < 4; ++j) uu[n][j] = acc[ai][0][m][n][j] * fsig(acc[ai][1][m][n][j]);
                    if (row < R) {
                        const unsigned ch = 128u * pn + cl;
                        *(u32x4*)(U + ((unsigned)row * 512u + ch)) = pack8(uu[0], uu[1]);
                        unsigned co = 0xffffffffu;
                        if (row < RP) { const unsigned t = row & (SEQ - 1); if (t >= SEQ - 30) co = (unsigned)O_CVP + ((l * BATCH + ((unsigned)row >> 11)) * 30u + (t - (SEQ - 30))) * D_A + ch; }
                        else { const unsigned sr = row - RP; co = (unsigned)O_CVS + ((l * DEC_BATCH + (sr >> 2)) * 30u + 26u + (sr & 3u)) * D_A + ch; }
                        if (co != 0xffffffffu) { *(f32x4*)(out + co) = uu[0]; *(f32x4*)(out + co + 4) = uu[1]; }
                    } asm volatile("" ::: "memory"); __builtin_amdgcn_sched_barrier(0); }
        } else if (pn >= 6 && pn <= 10) {
            int gsel = 0; bool do_norm = false, do_rope = false, has_dst = false; unsigned dsto = 0; int ld = 0, col = 0; int fsel = 0;
            if (pn < 8) { gsel = 1; do_norm = true; do_rope = true; has_dst = true; dsto = (unsigned)(A_Q / 2); ld = 512; col = (4 * (pn - 6) + wc) * 64; }
            else if (pn == 8) { if (wc < 2) { gsel = 2; do_norm = true; do_rope = true; has_dst = true; dsto = (unsigned)(A_K / 2); ld = 128; col = wc * 64; fsel = 1; }
                                else { has_dst = true; dsto = (unsigned)(A_V / 2); ld = 128; col = (wc - 2) * 64; fsel = 2; } }
            else if (pn == 9) { do_rope = true; has_dst = true; dsto = (unsigned)(A_QI / 2); ld = 256; col = wc * 64; }
            else { if (wc == 0) { do_norm = true; do_rope = true; has_dst = true; dsto = (unsigned)(A_KI / 2); ld = 64; col = 0; fsel = 3; } }
            bf16_t* const wsb = (bf16_t*)ws;
            if (pn == 10 && wc == 1) {
                if (fq == 0) { float* WI = (float*)(ws + A_WI);
#pragma unroll
                    for (int ai = 0; ai < 2; ++ai)
#pragma unroll
                        for (int m = 0; m < 4; ++m) { int row = rbase + ai * 128 + m * 16; asm volatile("" : "+v"(row));     if (row < R) *(f32x4*)(WI + (unsigned)row * 4u) = acc[ai][0][m][0]; } }
            } else if (has_dst) {
                const float* rope = (const float*)(ws + WS_ROPE); const float* gain = gsel == 1 ? a->q_norm_g + l * 64 : a->k_norm_g + l * 64;
#pragma unroll
                for (int ai = 0; ai < 2; ++ai)
#pragma unroll
                    for (int m = 0; m < 4; ++m) { int row = rbase + ai * 128 + m * 16; asm volatile("" : "+v"(row));
                        f32x4 x1[2] = {acc[ai][0][m][0], acc[ai][0][m][1]}, x2[2] = {acc[ai][1][m][0], acc[ai][1][m][1]};
                        if (do_norm) { float ss = 0.f;
#pragma unroll
                            for (int n = 0; n < 2; ++n)
#pragma unroll
                                for (int j = 0; j < 4; ++j) ss += x1[n][j] * x1[n][j] + x2[n][j] * x2[n][j];
                            ss += __shfl_xor(ss, 16); ss += __shfl_xor(ss, 32);
                            const float r = rsqrtf(ss * (1.f / 64.f) + EPS);
#pragma unroll
                            for (int n = 0; n < 2; ++n) { f32x4 g1 = (f32x4){1.f, 1.f, 1.f, 1.f}, g2 = g1;
                                if (gsel) { g1 = *(const f32x4*)(gain + 8 * fq + 4 * n); g2 = *(const f32x4*)(gain + 32 + 8 * fq + 4 * n); }
                                x1[n] = x1[n] * r * g1; x2[n] = x2[n] * r * g2; } }
#pragma unroll
                        for (int n = 0; n < 2; ++n) {
                            f32x4 o1 = x1[n], o2 = x2[n];
                            if (do_rope) { const float* rp = rope + ((unsigned)rope_slot(row) * 64u + 16u * fq + 8u * n); const f32x4 t0 = *(const f32x4*)rp, t1 = *(const f32x4*)(rp + 4);
                                const f32x4 cs = (f32x4){t0[0], t0[2], t1[0], t1[2]}, sn = (f32x4){t0[1], t0[3], t1[1], t1[3]};
                                o1 = x1[n] * cs - x2[n] * sn; o2 = x2[n] * cs + x1[n] * sn; }
                            if (row < R) {
                                const unsigned o = dsto + (unsigned)row * (unsigned)ld + (unsigned)col + 8u * fq + 4u * n;
                                typedef unsigned u32x2e __attribute__((ext_vector_type(2)));
                                *(u32x2e*)(wsb + o) = (u32x2e){pg8::cvt_pk_bf16(o1[0], o1[1]), pg8::cvt_pk_bf16(o1[2], o1[3])};
                                *(u32x2e*)(wsb + o + 32) = (u32x2e){pg8::cvt_pk_bf16(o2[0], o2[1]), pg8::cvt_pk_bf16(o2[2], o2[3])};
                                if (fsel) { unsigned fo;
                                    if (fsel == 1) fo = row < RP ? (unsigned)O_KP + ((unsigned)l * RP + row) * 128u : (unsigned)O_KS + ((unsigned)l * RS + (row - RP)) * 128u;
                                    else if (fsel == 2) fo = row < RP ? (unsigned)O_VP + ((unsigned)l * RP + row) * 128u : (unsigned)O_VS + ((unsigned)l * RS + (row - RP)) * 128u;
                                    else fo = row < RP ? (unsigned)O_IKP + ((unsigned)l * RP + row) * 64u : (unsigned)O_IKS + ((unsigned)l * RS + (row - RP)) * 64u;
                                    fo += (unsigned)col + 8u * fq + 4u * n;
                                    *(f32x4*)(out + fo) = o1; *(f32x4*)(out + fo + 32) = o2; }
                                if (fsel == 2 && row < RP) {
                                    bf16_t* vt = (bf16_t*)(ws + A_VT) + ((unsigned)((row >> 11) * 2 + (wc - 2)) * 64u + 8u * fq + 4u * n) * (unsigned)SEQ + (unsigned)(row & (SEQ - 1));
#pragma unroll
                                    for (int j = 0; j < 4; ++j) { vt[(unsigned)j * SEQ] = (bf16_t)f2bf(o1[j]); vt[(unsigned)(32 + j) * SEQ] = (bf16_t)f2bf(o2[j]); } } }
                            __builtin_amdgcn_sched_barrier(0);
                        }
                        asm volatile("" ::: "memory"); __builtin_amdgcn_sched_barrier(0); }
            }
        } else if (pn == 15 || pn == 16) {
            float* LF = (float*)(ws + A_LF); bf16_t* KK = (bf16_t*)(ws + A_KK); const float* lbw = (const float*)(ws + WS_LB) + l * C_FDIM;
#pragma unroll
            for (int ai = 0; ai < 2; ++ai)
#pragma unroll
                for (int m = 0; m < 4; ++m) { int row = rbase + ai * 128 + m * 16; asm volatile("" : "+v"(row));
#pragma unroll
                    for (int bj = 0; bj < 2; ++bj) { f32x4 lf[2], kk[2];
#pragma unroll
                        for (int n = 0; n < 2; ++n) { const f32x4 lbv = *(const f32x4*)(lbw + 256 * (pn - 15) + 128 * bj + cl + 4 * n);
#pragma unroll
                            for (int j = 0; j < 4; ++j) { const float fx = acc[ai][bj][m][n][j], lb = lbv[j];
                                const float e = __expf(-fabsf(fx)), r = __builtin_amdgcn_rcpf(1.f + e), er = e * r;
                                const float sp = fx >= 0.f ? r : er, sm = fx >= 0.f ? er : r;
                                lf[n][j] = __logf(fmaxf(lb, 1e-30f) + (1.f - lb) * sp); kk[n][j] = (1.f - lb) * sm; } }
                        if (row < R) { const unsigned o = (unsigned)row * 512u + 256u * (pn - 15) + 128u * bj + cl;
                            *(f32x4*)(LF + o) = lf[0]; *(f32x4*)(LF + o + 4) = lf[1]; *(u32x4*)(KK + o) = pack8(kk[0], kk[1]); } } __builtin_amdgcn_sched_barrier(0); }
        } else {
            bf16_t* dst; int ld, col0, act;
            if (pn < 6) { dst = (bf16_t*)(ws + A_AG); ld = 512; col0 = 256 * (pn - 4); act = 1; }
            else if (pn < 13) { dst = (bf16_t*)(ws + A_BG); ld = 512; col0 = 256 * (pn - 11); act = 1; }
            else if (pn < 15) { dst = (bf16_t*)(ws + A_CQ); ld = 512; col0 = 256 * (pn - 13); act = 1; }
            else if (pn < 19) { dst = (bf16_t*)(ws + A_CI); ld = 512; col0 = 256 * (pn - 17); act = 0; }
            else if (pn < 21) { dst = (bf16_t*)(ws + A_CG); ld = 512; col0 = 256 * (pn - 19); act = 1; }
            else if (pn < 25) { dst = (bf16_t*)(ws + A_GA); ld = 1024; col0 = 256 * (pn - 21); act = 2; }
            else if (pn < 29) { dst = (bf16_t*)(ws + A_GB); ld = 1024; col0 = 256 * (pn - 25); act = 2; }
            else { dst = (bf16_t*)(ws + A_GC); ld = 1024; col0 = 256 * (pn - 29); act = 2; }
#pragma unroll
            for (int ai = 0; ai < 2; ++ai)
#pragma unroll
                for (int m = 0; m < 4; ++m) { int row = rbase + ai * 128 + m * 16; asm volatile("" : "+v"(row));
#pragma unroll
                    for (int bj = 0; bj < 2; ++bj) { f32x4 v[2];
#pragma unroll
                        for (int n = 0; n < 2; ++n)
#pragma unroll
                            for (int j = 0; j < 4; ++j) { const float x = acc[ai][bj][m][n][j]; const float sg = fsig(x); v[n][j] = act == 0 ? x : (act == 1 ? x * sg : sg); }
                        if (row < R) *(u32x4*)(dst + ((unsigned)row * (unsigned)ld + (unsigned)col0 + 128u * bj + cl)) = pack8(v[0], v[1]); } __builtin_amdgcn_sched_barrier(0); }
        }
    }
};
constexpr int CW_HGE = 12416;
constexpr int HG_EARLY = 7;
struct InOrder : pg8::StaticOrder {
    unsigned* ctr;
    __device__ __forceinline__ bool next(int i, pg8::Unit& u) const {
        if (G != 256) return pg8::StaticOrder::next(i, u);
        if (c >= 224) { if (i >= 7) return false; return pg8::StaticOrder::next(i, u); }
        if (i == 8 && c >= 97 && c < 129) { InOrder t = *this; t.c = 224 + (c - 97); return t.pg8::StaticOrder::next(7, u); }
        return pg8::StaticOrder::next(i, u);
    }
    __device__ __forceinline__ void done(const pg8::Unit&, int ui) const {
        if (ui == 5) {
            asm volatile("s_waitcnt vmcnt(0)" ::: "memory");
            __builtin_amdgcn_s_barrier();
            if (threadIdx.x == 0) { __builtin_amdgcn_fence(__ATOMIC_RELEASE, "agent"); asm volatile("s_waitcnt vmcnt(0)" ::: "memory"); (void)__hip_atomic_fetch_add(ctr, 1u, __ATOMIC_RELAXED, __HIP_MEMORY_SCOPE_AGENT); }
        }
    }
};
__device__ __forceinline__ void phase_inproj(KA a, const Ctx& c, int l) {
    pg8::Gemm g{(const bf16_t*)(a->ws + WS_H), (const bf16_t*)(a->ws + WS_WTIN) + (size_t)l * NPAD * 1024, RPAD, NPAD, 1024};
    InOrder S; S.init(RPAD, NPAD, c.nblk, c.bid); S.ctr = (unsigned*)(a->ws + WS_CTL) + CW_HGE + 64 * l;
    EpiIn E{a, l};
    pg8::gemm_phase<EpiIn, InOrder, true, true>(c.lds_las, g, S, E, c.tid);
}

__device__ __forceinline__ void mix_conv(KA a, const Ctx& c, int l) {
    const bf16_t* U = (const bf16_t*)(a->ws + A_U); const bf16_t* AG = (const bf16_t*)(a->ws + A_AG); bf16_t* YA = (bf16_t*)(a->ws + A_YA);
    const float* wdw = a->w_dw + (size_t)l * CONV_W * D_A; const float* bdw = a->b_dw + l * D_A; const float* lg = a->ln_g + l * D_A; const float* lb = a->ln_b + l * D_A;
    float* red = (float*)c.lds;
    const int ch = c.tid;
    for (int row = c.bid; row < R; row += c.nblk) {
        float y = bdw[ch];
        if (row < RP) {
            const int t = row % SEQ;
            for (int j = 0; j < CONV_W; ++j) { const int ft = t + j - 30; if (ft >= 0) y += wdw[j * D_A + ch] * LD(U, (size_t)(row - t + ft) * 512 + ch); }
        } else {
            const int b = (row - RP) / DEC_SEQ, t = (row - RP) % DEC_SEQ; const float* buf = a->state_conv + ((size_t)l * DEC_BATCH + b) * 30 * D_A;
            for (int j = 0; j < CONV_W; ++j) { const int f = t + j; const float v = f < 30 ? buf[f * D_A + ch] : LD(U, (size_t)(RP + b * DEC_SEQ + (f - 30)) * 512 + ch); y += wdw[j * D_A + ch] * v; }
        }
        const float mu = block_sum(c, y, red) * (1.f / D_A);
        const float d = y - mu;
        const float var = block_sum(c, d * d, red) * (1.f / D_A);
        const float ln = d * rsqrtf(var + EPS) * lg[ch] + lb[ch];
        YA[(size_t)row * 512 + ch] = (bf16_t)f2bf(silu_f(ln) * LD(AG, (size_t)row * 512 + ch));
    }
    const int gtid = c.bid * NT + c.tid, gn = c.nblk * NT;
    for (int i = gtid; i < DEC_BATCH * 26 * D_A; i += gn) { const int chn = i % D_A, j = (i / D_A) % 26, b = i / (D_A * 26);
        a->out[O_CVS + (((size_t)l * DEC_BATCH + b) * 30 + j) * D_A + chn] = a->state_conv[(((size_t)l * DEC_BATCH + b) * 30 + j + DEC_SEQ) * D_A + chn]; }
}

__device__ __forceinline__ void mix_hgrn(KA a, const Ctx& c, int l, int it_first, int it_end) {
    const bf16_t* CQ = (const bf16_t*)(a->ws + A_CQ); const float* LF = (const float*)(a->ws + A_LF); const bf16_t* KK = (const bf16_t*)(a->ws + A_KK);
    const bf16_t* CI = (const bf16_t*)(a->ws + A_CI); const bf16_t* CG = (const bf16_t*)(a->ws + A_CG); bf16_t* YC = (bf16_t*)(a->ws + A_YC);
    const float* cg = a->c_norm_g + l * C_VDIM;
    float* sq = (float*)c.lds; float* sf = sq + 128; float* sk = sf + 128; float* part = sk + 128;   float* red = part + 512;
    const int v = c.tid & 127, dg = c.tid >> 7;
    const int nitems = (BATCH + DEC_BATCH) * C_HEADS;
    (void)nitems;
    for (int it = it_first; it < it_end; it += c.nblk) {
        const int bb = it / C_HEADS, h = it % C_HEADS; const bool pr = bb < BATCH;
        const int T = pr ? SEQ : DEC_SEQ; const int row0 = pr ? bb * SEQ : RP + (bb - BATCH) * DEC_SEQ;
        float S[32];
        if (pr) {
#pragma unroll
            for (int j = 0; j < 32; ++j) S[j] = 0.f;
        } else {
            const float* s0 = a->state_hgrn + (((size_t)l * DEC_BATCH + (bb - BATCH)) * C_HEADS + h) * C_KDIM * C_VDIM;
#pragma unroll
            for (int j = 0; j < 32; ++j) S[j] = s0[(size_t)(dg * 32 + j) * C_VDIM + v];
        }
        for (int t = 0; t < T; ++t) {
            const size_t ro = (size_t)(row0 + t) * 512 + h * 128;
            __syncthreads();
            if (c.tid < 128) { sq[c.tid] = LD(CQ, ro + c.tid); sf[c.tid] = expf(LF[ro + c.tid]); sk[c.tid] = LD(KK, ro + c.tid); }
            const float iv = LD(CI, ro + v);
            __syncthreads();
            float p = 0.f;
#pragma unroll
            for (int j = 0; j < 32; ++j) { const int d = dg * 32 + j; S[j] = sf[d] * S[j] + sk[d] * iv; p += S[j] * sq[d]; }
            part[dg * 128 + v] = p;
            __syncthreads();
            float o = 0.f, ss = 0.f;
            if (c.tid < 128) { o = part[v] + part[128 + v] + part[256 + v] + part[384 + v]; ss = wave_sum(o * o); if (c.lane == 0) red[c.wave] = ss; }
            __syncthreads();
            if (c.tid < 128) { const float tot = red[0] + red[1]; YC[ro + v] = (bf16_t)f2bf(o * rsqrtf(tot * (1.f / 128.f) + EPS) * cg[v] * LD(CG, ro + v)); }
        }
        float* so = pr ? a->out + O_HGP + (((size_t)l * BATCH + bb) * C_HEADS + h) * C_KDIM * C_VDIM : a->out + O_HGS + (((size_t)l * DEC_BATCH + (bb - BATCH)) * C_HEADS + h) * C_KDIM * C_VDIM;
#pragma unroll
        for (int j = 0; j < 32; ++j) so[(size_t)(dg * 32 + j) * C_VDIM + v] = S[j];
    }
}

__device__ __forceinline__ unsigned fkey(float f) { const unsigned u = __float_as_uint(f); return (u & 0x80000000u) ? ~u : (u | 0x80000000u); }
__device__ __forceinline__ void mix_dsa(KA a, const Ctx& c, int l, int row_first, int row_end) {
    const bf16_t* Q = (const bf16_t*)(a->ws + A_Q); const bf16_t* Kb = (const bf16_t*)(a->ws + A_K); const bf16_t* Vb = (const bf16_t*)(a->ws + A_V);
    const bf16_t* QI = (const bf16_t*)(a->ws + A_QI); const bf16_t* KI = (const bf16_t*)(a->ws + A_KI); const float* WI = (const float*)(a->ws + A_WI);
    const bf16_t* BG = (const bf16_t*)(a->ws + A_BG); bf16_t* YB = (bf16_t*)(a->ws + A_YB);
    const float* ck = a->cache_k + (size_t)l * N_POOL * PAGE * KV_DIM; const float* cv = a->cache_v + (size_t)l * N_POOL * PAGE * KV_DIM;
    const float* cki = a->cache_idx_k + (size_t)l * N_POOL * PAGE * IDX_DIM;
    unsigned* keys = (unsigned*)c.lds;
    float* sqi = (float*)(keys + 8256);
    float* sq = sqi + 256;
    int* sel = (int*)(sq + 512);
    float* att = (float*)(sel + 256);
    int* cnt = (int*)(att + 2048);
    float* red = (float*)(cnt + 4);
    int* spt = (int*)(red + 16);
    int* prow = spt + 64;
    int* newslot = prow + 256;
    for (int row = row_first; row < row_end; row += c.nblk) {
        const bool pr = row < RP; const int b = pr ? row / SEQ : (row - RP) / DEC_SEQ, t = pr ? row % SEQ : (row - RP) % DEC_SEQ;
        const int nkeys = pr ? t + 1 : PAST_LEN + t + 1;
        const int* pt = a->page_table + b * N_PAGES;
        __syncthreads();
        if (c.tid < 256) sqi[c.tid] = LD(QI, (unsigned)row * 256u + c.tid);
        sq[c.tid] = LD(Q, (unsigned)row * 512u + c.tid) * 0.125f;
        if (c.tid == 0) cnt[0] = 0;
        if (c.tid < N_PAGES) spt[c.tid] = pt[c.tid];
        if (c.tid < 4) newslot[c.tid] = -1;
        const float w0 = WI[(unsigned)row * 4u + 0], w1 = WI[(unsigned)row * 4u + 1], w2 = WI[(unsigned)row * 4u + 2], w3 = WI[(unsigned)row * 4u + 3];
        __syncthreads();
        if (!pr) {
            const int c16 = c.lane & 15, g = c.lane >> 4;
            bf16x8_t Aq[2];
#pragma unroll
            for (int ks = 0; ks < 2; ++ks) { Aq[ks] = (bf16x8_t){0, 0, 0, 0, 0, 0, 0, 0}; if (c16 < 4) Aq[ks] = *(const bf16x8_t*)(QI + ((unsigned)row * 256u + c16 * 64 + 32 * ks + 8 * g)); }
#pragma unroll 1
            for (int nt0 = c.wave; nt0 < PAST_LEN / 16; nt0 += 64) {
                float4 kr[8][4];
#pragma unroll
                for (int q = 0; q < 8; ++q) { const int s = 16 * (nt0 + 8 * q) + c16;
                    const float* kp = cki + ((size_t)spt[s >> 7] * PAGE + (s & (PAGE - 1))) * 64 + 8 * g;
                    kr[q][0] = *(const float4*)kp; kr[q][1] = *(const float4*)(kp + 4); kr[q][2] = *(const float4*)(kp + 32); kr[q][3] = *(const float4*)(kp + 36); }
#pragma unroll
                for (int q = 0; q < 8; ++q) { const int s = 16 * (nt0 + 8 * q) + c16;
                    const u32x4 b0 = (u32x4){pg8::cvt_pk_bf16(kr[q][0].x, kr[q][0].y), pg8::cvt_pk_bf16(kr[q][0].z, kr[q][0].w), pg8::cvt_pk_bf16(kr[q][1].x, kr[q][1].y), pg8::cvt_pk_bf16(kr[q][1].z, kr[q][1].w)};
                    const u32x4 b1 = (u32x4){pg8::cvt_pk_bf16(kr[q][2].x, kr[q][2].y), pg8::cvt_pk_bf16(kr[q][2].z, kr[q][2].w), pg8::cvt_pk_bf16(kr[q][3].x, kr[q][3].y), pg8::cvt_pk_bf16(kr[q][3].z, kr[q][3].w)};
                    f32x4 acc = (f32x4){0.f, 0.f, 0.f, 0.f};
                    acc = __builtin_amdgcn_mfma_f32_16x16x32_bf16(Aq[0], __builtin_bit_cast(bf16x8_t, b0), acc, 0, 0, 0);
                    acc = __builtin_amdgcn_mfma_f32_16x16x32_bf16(Aq[1], __builtin_bit_cast(bf16x8_t, b1), acc, 0, 0, 0);
                    if (g == 0) { float sc = fmaxf(acc[0] * 0.125f, 0.f) * w0;
                        sc += fmaxf(acc[1] * 0.125f, 0.f) * w1; sc += fmaxf(acc[2] * 0.125f, 0.f) * w2; sc += fmaxf(acc[3] * 0.125f, 0.f) * w3;
                        keys[s] = fkey(sc * 0.5f); } }
            }
        }
        for (int s = (pr ? 0 : PAST_LEN) + c.tid; s < nkeys; s += NT) {
            const float* kpf = nullptr; const bf16_t* kpb = nullptr;
            if (pr) kpb = KI + (size_t)(b * SEQ + s) * 64;
            else if (s < PAST_LEN) kpf = cki + ((size_t)spt[s / PAGE] * PAGE + (s % PAGE)) * 64;
            else kpb = KI + (size_t)(RP + b * DEC_SEQ + (s - PAST_LEN)) * 64;
            float d0 = 0.f, d1 = 0.f, d2 = 0.f, d3 = 0.f;
            if (kpf) {
                float4 kq[16];
#pragma unroll
                for (int q = 0; q < 16; ++q) kq[q] = ((const float4*)kpf)[q];
#pragma unroll
                for (int q = 0; q < 16; ++q) { const int j = 4 * q;
                    const float4 q0 = *(const float4*)(sqi + j), q1 = *(const float4*)(sqi + 64 + j), q2 = *(const float4*)(sqi + 128 + j), q3 = *(const float4*)(sqi + 192 + j);
                    d0 += q0.x * kq[q].x + q0.y * kq[q].y + q0.z * kq[q].z + q0.w * kq[q].w;
                    d1 += q1.x * kq[q].x + q1.y * kq[q].y + q1.z * kq[q].z + q1.w * kq[q].w;
                    d2 += q2.x * kq[q].x + q2.y * kq[q].y + q2.z * kq[q].z + q2.w * kq[q].w;
                    d3 += q3.x * kq[q].x + q3.y * kq[q].y + q3.z * kq[q].z + q3.w * kq[q].w; }
            } else {
#pragma unroll 1
                for (int j = 0; j < 64; j += 8) { float kv[8]; ld8(kpb + j, kv);
#pragma unroll
                    for (int q = 0; q < 8; ++q) { d0 += sqi[j + q] * kv[q]; d1 += sqi[64 + j + q] * kv[q]; d2 += sqi[128 + j + q] * kv[q]; d3 += sqi[192 + j + q] * kv[q]; } }
            }
            float sc = fmaxf(d0 * 0.125f, 0.f) * w0;
            sc += fmaxf(d1 * 0.125f, 0.f) * w1; sc += fmaxf(d2 * 0.125f, 0.f) * w2; sc += fmaxf(d3 * 0.125f, 0.f) * w3;
            keys[s] = fkey(sc * 0.5f);
        }
        __syncthreads();
        int nsel;
        if (nkeys <= TOPK) {
            if (c.tid < nkeys) sel[c.tid] = c.tid;
            nsel = nkeys;
        } else {
            unsigned* HS = (unsigned*)(att);
            unsigned prefix = 0u; int need = TOPK;
#pragma unroll 1
            for (int pass = 0; pass < 4; ++pass) {
                const int shift = 24 - 8 * pass; const unsigned himask = pass == 0 ? 0u : (0xffffffffu << (shift + 8));
                __syncthreads();
                for (int i = c.tid; i < 2048; i += NT) HS[i] = 0u;
                __syncthreads();
                for (int s = c.tid; s < nkeys; s += NT) { const unsigned kk = keys[s]; if ((kk & himask) == prefix) atomicAdd(&HS[c.wave * 256 + ((kk >> shift) & 255u)], 1u); }
                __syncthreads();
                int c4[4];
#pragma unroll
                for (int q = 0; q < 4; ++q) { unsigned t = 0u;
#pragma unroll
                    for (int w8 = 0; w8 < 8; ++w8) t += HS[w8 * 256 + 4 * c.lane + q];
                    c4[q] = (int)t; }
                const int ssum = c4[0] + c4[1] + c4[2] + c4[3];
                int pre = ssum;
                pre += __builtin_amdgcn_update_dpp(0, pre, 0x111, 0xf, 0xf, false);
                pre += __builtin_amdgcn_update_dpp(0, pre, 0x112, 0xf, 0xf, false);
                pre += __builtin_amdgcn_update_dpp(0, pre, 0x114, 0xf, 0xf, false);
                pre += __builtin_amdgcn_update_dpp(0, pre, 0x118, 0xf, 0xf, false);
                pre += __builtin_amdgcn_update_dpp(0, pre, 0x142, 0xa, 0xf, false);
                pre += __builtin_amdgcn_update_dpp(0, pre, 0x143, 0xc, 0xf, false);
                const int total = __builtin_amdgcn_readlane(pre, 63);
                const int suf = total - pre + ssum;
                const unsigned long long m = __ballot(suf >= need);
                const int L = 63 - __clzll(m);
                const int above = L < 63 ? __builtin_amdgcn_readlane(suf, (L + 1) & 63) : 0;
                const int cy = __builtin_amdgcn_readlane(c4[1], L), cz = __builtin_amdgcn_readlane(c4[2], L), cw = __builtin_amdgcn_readlane(c4[3], L);
                int q, ab;
                if (above + cw >= need) { q = 3; ab = above; } else if (above + cw + cz >= need) { q = 2; ab = above + cw; } else if (above + cw + cz + cy >= need) { q = 1; ab = above + cw + cz; } else { q = 0; ab = above + cw + cz + cy; }
                prefix |= (unsigned)(4 * L + q) << shift; need -= ab;
            }
            __syncthreads();
            for (int s = c.tid; s < nkeys; s += NT) if (keys[s] > prefix) { const int p = atomicAdd(&cnt[0], 1); sel[p] = s; }
            __syncthreads();
            const int ngt = cnt[0];
            if (c.wave == 0) {
                int taken = ngt;
                for (int s0 = 0; s0 < nkeys && taken < TOPK; s0 += 64) {
                    const int s = s0 + c.lane; const bool tie = (s < nkeys) && (keys[s] == prefix);
                    const unsigned long long m = __ballot(tie);
                    const int before = __popcll(m & ((1ull << c.lane) - 1ull));
                    if (tie && taken + before < TOPK) sel[taken + before] = s;
                    taken += __popcll(m);
                }
            }
            nsel = TOPK;
        }
        __syncthreads();
        {
            const int slot = c.tid & 255, n = c.tid >> 8;
            if (slot < nsel) {
                const int s = sel[slot]; const float* kpf = nullptr; const bf16_t* kpb = nullptr; int pw = -1, ns = -1;
                if (pr) { kpb = Kb + (size_t)(b * SEQ + s) * 128; }
                else if (s < PAST_LEN) { const int rr = spt[s / PAGE] * PAGE + (s % PAGE); kpf = ck + (size_t)rr * 128; pw = rr; }
                else { const int rr = RP + b * DEC_SEQ + (s - PAST_LEN); kpb = Kb + (size_t)rr * 128; ns = s - PAST_LEN; }
                if (n == 0) { prow[slot] = pw; if (ns >= 0) newslot[ns] = slot; }
                float kv[64];
                if (kpb) {
#pragma unroll
                    for (int i = 0; i < 8; ++i) { float t8[8]; ld8(kpb + 64 * n + 8 * i, t8);
#pragma unroll
                        for (int e = 0; e < 8; ++e) kv[8 * i + e] = t8[e]; }
                } else {
#pragma unroll
                    for (int i = 0; i < 16; ++i) { const float4 t4 = *(const float4*)(kpf + 64 * n + 4 * i); kv[4 * i] = t4.x; kv[4 * i + 1] = t4.y; kv[4 * i + 2] = t4.z; kv[4 * i + 3] = t4.w; }
                }
#pragma unroll
                for (int h = 0; h < 4; ++h) { const float* qp = sq + (4 * n + h) * 64; float dd = 0.f;
#pragma unroll
                    for (int i = 0; i < 16; ++i) { const float4 q4 = *(const float4*)(qp + 4 * i); dd += q4.x * kv[4 * i] + q4.y * kv[4 * i + 1] + q4.z * kv[4 * i + 2] + q4.w * kv[4 * i + 3]; }
                    att[(4 * n + h) * 256 + slot] = dd; }
            }
        }
        __syncthreads();
        {
            const int h = c.wave; float mx = -3.0e38f;
            for (int j = c.lane; j < nsel; j += 64) mx = fmaxf(mx, att[h * 256 + j]);
            mx = wave_max(mx);
            float sum = 0.f;
            for (int j = c.lane; j < nsel; j += 64) { const float e = __expf(att[h * 256 + j] - mx); att[h * 256 + j] = e; sum += e; }
            sum = wave_sum(sum);
            const float inv = 1.f / sum;
            for (int j = c.lane; j < nsel; j += 64) att[h * 256 + j] *= inv;
        }
        __syncthreads();
        {
            const int h = c.wave, n = h >> 2, ks = c.lane >> 4, d4 = c.lane & 15;
            float o0 = 0.f, o1 = 0.f, o2 = 0.f, o3 = 0.f;
#pragma unroll 1
            for (int j0 = 0; j0 < 256; j0 += 64) {
                float4 vv[16]; float pw[16];
#pragma unroll
                for (int q = 0; q < 16; ++q) { const int j = j0 + 4 * q + ks; const int rr = j < nsel ? prow[j] : -1; const bool ok = rr >= 0;
                    pw[q] = ok ? att[h * 256 + j] : 0.f;
                    vv[q] = *(const float4*)(cv + (size_t)(ok ? rr : 0) * 128 + n * 64 + 4 * d4); }
#pragma unroll
                for (int q = 0; q < 16; ++q) { o0 += pw[q] * vv[q].x; o1 += pw[q] * vv[q].y; o2 += pw[q] * vv[q].z; o3 += pw[q] * vv[q].w; }
            }
            if (ks == 0) {
#pragma unroll
                for (int tt = 0; tt < DEC_SEQ; ++tt) { const int jn = newslot[tt]; if (jn >= 0) { const float wn = att[h * 256 + jn]; const bf16_t* vp = Vb + (size_t)(RP + b * DEC_SEQ + tt) * 128 + n * 64 + 4 * d4;
                    o0 += wn * bf2f(vp[0]); o1 += wn * bf2f(vp[1]); o2 += wn * bf2f(vp[2]); o3 += wn * bf2f(vp[3]); } }
            }
            o0 += __shfl_xor(o0, 16); o1 += __shfl_xor(o1, 16); o2 += __shfl_xor(o2, 16); o3 += __shfl_xor(o3, 16);
            o0 += __shfl_xor(o0, 32); o1 += __shfl_xor(o1, 32); o2 += __shfl_xor(o2, 32); o3 += __shfl_xor(o3, 32);
            if (ks == 0) { const unsigned e = (unsigned)row * 512u + h * 64 + 4 * d4;
                YB[e] = (bf16_t)f2bf(o0 * LD(BG, e)); YB[e + 1] = (bf16_t)f2bf(o1 * LD(BG, e + 1)); YB[e + 2] = (bf16_t)f2bf(o2 * LD(BG, e + 2)); YB[e + 3] = (bf16_t)f2bf(o3 * LD(BG, e + 3)); }
        }
    }
}

constexpr int DSA_TPI = 2;
__device__ __forceinline__ void mix_dsa4(KA a, const Ctx& c, int l, int b, int tp) {
    const bf16_t* Q = (const bf16_t*)(a->ws + A_Q); const bf16_t* Kb = (const bf16_t*)(a->ws + A_K); const bf16_t* Vb = (const bf16_t*)(a->ws + A_V);
    const bf16_t* QI = (const bf16_t*)(a->ws + A_QI); const bf16_t* KI = (const bf16_t*)(a->ws + A_KI); const float* WI = (const float*)(a->ws + A_WI);
    const bf16_t* BG = (const bf16_t*)(a->ws + A_BG); bf16_t* YB = (bf16_t*)(a->ws + A_YB);
    const float* ck = a->cache_k + (size_t)l * N_POOL * PAGE * KV_DIM; const float* cv = a->cache_v + (size_t)l * N_POOL * PAGE * KV_DIM;
    const float* cki = a->cache_idx_k + (size_t)l * N_POOL * PAGE * IDX_DIM;
    unsigned* keys4 = (unsigned*)c.lds;
    float* sqi = (float*)(keys4 + DSA_TPI * 8256);
    float* sq = sqi + 256;
    int* sel = (int*)(sq + 512);
    float* att = (float*)(sel + 256);
    int* cnt = (int*)(att + 2048);
    float* red = (float*)(cnt + 4);
    int* spt = (int*)(red + 16);
    int* prow = spt + 64;
    int* newslot = prow + 256;
    static_assert((DSA_TPI * 8256 + 256 + 512 + 256 + 2048 + 4 + 16 + 64 + 256 + 4) * 4 <= LDS_BYTES - 128, "mix_dsa4 LDS carve");
    (void)red;
    const bool pr = false;
    __syncthreads();
    if (c.tid < N_PAGES) spt[c.tid] = a->page_table[b * N_PAGES + c.tid];
    __syncthreads();
    {
        const int c16 = c.lane & 15, g = c.lane >> 4;
        bf16x8_t Aq[2]; float wq[4];
#pragma unroll
        for (int ks = 0; ks < 2; ++ks) { Aq[ks] = (bf16x8_t){0, 0, 0, 0, 0, 0, 0, 0}; if ((c16 >> 2) < DSA_TPI) Aq[ks] = *(const bf16x8_t*)(QI + ((unsigned)(RP + b * DEC_SEQ + DSA_TPI * tp + (c16 >> 2)) * 256u + (c16 & 3) * 64 + 32 * ks + 8 * g)); }
        { const int gt = g < DSA_TPI ? g : 0; const f32x4 w4 = *(const f32x4*)(WI + (unsigned)(RP + b * DEC_SEQ + DSA_TPI * tp + gt) * 4u); wq[0] = w4[0]; wq[1] = w4[1]; wq[2] = w4[2]; wq[3] = w4[3]; }
        float4 ka_[4][4], kb_[4][4];
#define SD_LD(set_, j0_) do { _Pragma("unroll") for (int q = 0; q < 4; ++q) { const int s_ = 16 * (c.wave + 8 * ((j0_) + q)) + c16; \
            const float* kp_ = cki + ((size_t)spt[s_ >> 7] * PAGE + (s_ & (PAGE - 1))) * 64 + 8 * g; \
            set_[q][0] = *(const float4*)kp_; set_[q][1] = *(const float4*)(kp_ + 4); set_[q][2] = *(const float4*)(kp_ + 32); set_[q][3] = *(const float4*)(kp_ + 36); } } while (0)
#define SD_CP(set_, j0_) do { _Pragma("unroll") for (int q = 0; q < 4; ++q) { const int s_ = 16 * (c.wave + 8 * ((j0_) + q)) + c16; \
            const u32x4 b0_ = (u32x4){pg8::cvt_pk_bf16(set_[q][0].x, set_[q][0].y), pg8::cvt_pk_bf16(set_[q][0].z, set_[q][0].w), pg8::cvt_pk_bf16(set_[q][1].x, set_[q][1].y), pg8::cvt_pk_bf16(set_[q][1].z, set_[q][1].w)}; \
            const u32x4 b1_ = (u32x4){pg8::cvt_pk_bf16(set_[q][2].x, set_[q][2].y), pg8::cvt_pk_bf16(set_[q][2].z, set_[q][2].w), pg8::cvt_pk_bf16(set_[q][3].x, set_[q][3].y), pg8::cvt_pk_bf16(set_[q][3].z, set_[q][3].w)}; \
            f32x4 acc_ = (f32x4){0.f, 0.f, 0.f, 0.f}; \
            acc_ = __builtin_amdgcn_mfma_f32_16x16x32_bf16(Aq[0], __builtin_bit_cast(bf16x8_t, b0_), acc_, 0, 0, 0); \
            acc_ = __builtin_amdgcn_mfma_f32_16x16x32_bf16(Aq[1], __builtin_bit_cast(bf16x8_t, b1_), acc_, 0, 0, 0); \
            float sc_ = fmaxf(acc_[0] * 0.125f, 0.f) * wq[0]; sc_ += fmaxf(acc_[1] * 0.125f, 0.f) * wq[1]; sc_ += fmaxf(acc_[2] * 0.125f, 0.f) * wq[2]; sc_ += fmaxf(acc_[3] * 0.125f, 0.f) * wq[3]; \
            if (g < DSA_TPI) keys4[g * 8256 + s_] = fkey(sc_ * 0.5f); } } while (0)
        SD_LD(ka_, 0);
#pragma unroll 1
        for (int j0 = 0; j0 < 64; j0 += 8) {
            SD_LD(kb_, j0 + 4);
            SD_CP(ka_, j0);
            { const int jn = j0 + 8 < 64 ? j0 + 8 : 56; SD_LD(ka_, jn); }
            SD_CP(kb_, j0 + 4);
        }
#undef SD_LD
#undef SD_CP
    }
    __syncthreads();
#pragma unroll 1
    for (int tt_ = 0; tt_ < DSA_TPI; ++tt_) {
        const int t = DSA_TPI * tp + tt_, row = RP + b * DEC_SEQ + t, nkeys = PAST_LEN + t + 1;
        unsigned* keys = keys4 + tt_ * 8256;
        __syncthreads();
        if (c.tid < 256) sqi[c.tid] = LD(QI, (unsigned)row * 256u + c.tid);
        sq[c.tid] = LD(Q, (unsigned)row * 512u + c.tid) * 0.125f;
        if (c.tid == 0) cnt[0] = 0;
        if (c.tid < 4) newslot[c.tid] = -1;
        const float w0 = WI[(unsigned)row * 4u + 0], w1 = WI[(unsigned)row * 4u + 1], w2 = WI[(unsigned)row * 4u + 2], w3 = WI[(unsigned)row * 4u + 3];
        __syncthreads();
        for (int s = (pr ? 0 : PAST_LEN) + c.tid; s < nkeys; s += NT) {
            const float* kpf = nullptr; const bf16_t* kpb = nullptr;
            if (pr) kpb = KI + (size_t)(b * SEQ + s) * 64;
            else if (s < PAST_LEN) kpf = cki + ((size_t)spt[s / PAGE] * PAGE + (s % PAGE)) * 64;
            else kpb = KI + (size_t)(RP + b * DEC_SEQ + (s - PAST_LEN)) * 64;
            float d0 = 0.f, d1 = 0.f, d2 = 0.f, d3 = 0.f;
            if (kpf) {
                float4 kq[16];
#pragma unroll
                for (int q = 0; q < 16; ++q) kq[q] = ((const float4*)kpf)[q];
#pragma unroll
                for (int q = 0; q < 16; ++q) { const int j = 4 * q;
                    const float4 q0 = *(const float4*)(sqi + j), q1 = *(const float4*)(sqi + 64 + j), q2 = *(const float4*)(sqi + 128 + j), q3 = *(const float4*)(sqi + 192 + j);
                    d0 += q0.x * kq[q].x + q0.y * kq[q].y + q0.z * kq[q].z + q0.w * kq[q].w;
                    d1 += q1.x * kq[q].x + q1.y * kq[q].y + q1.z * kq[q].z + q1.w * kq[q].w;
                    d2 += q2.x * kq[q].x + q2.y * kq[q].y + q2.z * kq[q].z + q2.w * kq[q].w;
                    d3 += q3.x * kq[q].x + q3.y * kq[q].y + q3.z * kq[q].z + q3.w * kq[q].w; }
            } else {
#pragma unroll 1
                for (int j = 0; j < 64; j += 8) { float kv[8]; ld8(kpb + j, kv);
#pragma unroll
                    for (int q = 0; q < 8; ++q) { d0 += sqi[j + q] * kv[q]; d1 += sqi[64 + j + q] * kv[q]; d2 += sqi[128 + j + q] * kv[q]; d3 += sqi[192 + j + q] * kv[q]; } }
            }
            float sc = fmaxf(d0 * 0.125f, 0.f) * w0;
            sc += fmaxf(d1 * 0.125f, 0.f) * w1; sc += fmaxf(d2 * 0.125f, 0.f) * w2; sc += fmaxf(d3 * 0.125f, 0.f) * w3;
            keys[s] = fkey(sc * 0.5f);
        }
        __syncthreads();
        int nsel;
        if (nkeys <= TOPK) {
            if (c.tid < nkeys) sel[c.tid] = c.tid;
            nsel = nkeys;
        } else {
            unsigned* HS = (unsigned*)(att);
            unsigned prefix = 0u; int need = TOPK;
#pragma unroll 1
            for (int pass = 0; pass < 4; ++pass) {
                const int shift = 24 - 8 * pass; const unsigned himask = pass == 0 ? 0u : (0xffffffffu << (shift + 8));
                __syncthreads();
                for (int i = c.tid; i < 2048; i += NT) HS[i] = 0u;
                __syncthreads();
                for (int s = c.tid; s < nkeys; s += NT) { const unsigned kk = keys[s]; if ((kk & himask) == prefix) atomicAdd(&HS[c.wave * 256 + ((kk >> shift) & 255u)], 1u); }
                __syncthreads();
                int c4[4];
#pragma unroll
                for (int q = 0; q < 4; ++q) { unsigned t = 0u;
#pragma unroll
                    for (int w8 = 0; w8 < 8; ++w8) t += HS[w8 * 256 + 4 * c.lane + q];
                    c4[q] = (int)t; }
                const int ssum = c4[0] + c4[1] + c4[2] + c4[3];
                int pre = ssum;
                pre += __builtin_amdgcn_update_dpp(0, pre, 0x111, 0xf, 0xf, false);
                pre += __builtin_amdgcn_update_dpp(0, pre, 0x112, 0xf, 0xf, false);
                pre += __builtin_amdgcn_update_dpp(0, pre, 0x114, 0xf, 0xf, false);
                pre += __builtin_amdgcn_update_dpp(0, pre, 0x118, 0xf, 0xf, false);
                pre += __builtin_amdgcn_update_dpp(0, pre, 0x142, 0xa, 0xf, false);
                pre += __builtin_amdgcn_update_dpp(0, pre, 0x143, 0xc, 0xf, false);
                const int total = __builtin_amdgcn_readlane(pre, 63);
                const int suf = total - pre + ssum;
                const unsigned long long m = __ballot(suf >= need);
                const int L = 63 - __clzll(m);
                const int above = L < 63 ? __builtin_amdgcn_readlane(suf, (L + 1) & 63) : 0;
                const int cy = __builtin_amdgcn_readlane(c4[1], L), cz = __builtin_amdgcn_readlane(c4[2], L), cw = __builtin_amdgcn_readlane(c4[3], L);
                int q, ab;
                if (above + cw >= need) { q = 3; ab = above; } else if (above + cw + cz >= need) { q = 2; ab = above + cw; } else if (above + cw + cz + cy >= need) { q = 1; ab = above + cw + cz; } else { q = 0; ab = above + cw + cz + cy; }
                prefix |= (unsigned)(4 * L + q) << shift; need -= ab;
            }
            __syncthreads();
            for (int s = c.tid; s < nkeys; s += NT) if (keys[s] > prefix) { const int p = atomicAdd(&cnt[0], 1); sel[p] = s; }
            __syncthreads();
            const int ngt = cnt[0];
            if (c.wave == 0) {
                int taken = ngt;
                for (int s0 = 0; s0 < nkeys && taken < TOPK; s0 += 64) {
                    const int s = s0 + c.lane; const bool tie = (s < nkeys) && (keys[s] == prefix);
                    const unsigned long long m = __ballot(tie);
                    const int before = __popcll(m & ((1ull << c.lane) - 1ull));
                    if (tie && taken + before < TOPK) sel[taken + before] = s;
                    taken += __popcll(m);
                }
            }
            nsel = TOPK;
        }
        __syncthreads();
        {
            const int slot = c.tid & 255, n = c.tid >> 8;
            if (slot < nsel) {
                const int s = sel[slot]; const float* kpf = nullptr; const bf16_t* kpb = nullptr; int pw = -1, ns = -1;
                if (pr) { kpb = Kb + (size_t)(b * SEQ + s) * 128; }
                else if (s < PAST_LEN) { const int rr = spt[s / PAGE] * PAGE + (s % PAGE); kpf = ck + (size_t)rr * 128; pw = rr; }
                else { const int rr = RP + b * DEC_SEQ + (s - PAST_LEN); kpb = Kb + (size_t)rr * 128; ns = s - PAST_LEN; }
                if (n == 0) { prow[slot] = pw; if (ns >= 0) newslot[ns] = slot; }
                float kv[64];
                if (kpb) {
#pragma unroll
                    for (int i = 0; i < 8; ++i) { float t8[8]; ld8(kpb + 64 * n + 8 * i, t8);
#pragma unroll
                        for (int e = 0; e < 8; ++e) kv[8 * i + e] = t8[e]; }
                } else {
#pragma unroll
                    for (int i = 0; i < 16; ++i) { const float4 t4 = *(const float4*)(kpf + 64 * n + 4 * i); kv[4 * i] = t4.x; kv[4 * i + 1] = t4.y; kv[4 * i + 2] = t4.z; kv[4 * i + 3] = t4.w; }
                }
#pragma unroll
                for (int h = 0; h < 4; ++h) { const float* qp = sq + (4 * n + h) * 64; float dd = 0.f;
#pragma unroll
                    for (int i = 0; i < 16; ++i) { const float4 q4 = *(const float4*)(qp + 4 * i); dd += q4.x * kv[4 * i] + q4.y * kv[4 * i + 1] + q4.z * kv[4 * i + 2] + q4.w * kv[4 * i + 3]; }
                    att[(4 * n + h) * 256 + slot] = dd; }
            }
        }
        __syncthreads();
        {
            const int h = c.wave; float mx = -3.0e38f;
            for (int j = c.lane; j < nsel; j += 64) mx = fmaxf(mx, att[h * 256 + j]);
            mx = wave_max(mx);
            float sum = 0.f;
            for (int j = c.lane; j < nsel; j += 64) { const float e = __expf(att[h * 256 + j] - mx); att[h * 256 + j] = e; sum += e; }
            sum = wave_sum(sum);
            const float inv = 1.f / sum;
            for (int j = c.lane; j < nsel; j += 64) att[h * 256 + j] *= inv;
        }
        __syncthreads();
        {
            const int h = c.wave, n = h >> 2, ks = c.lane >> 4, d4 = c.lane & 15;
            float o0 = 0.f, o1 = 0.f, o2 = 0.f, o3 = 0.f;
#pragma unroll 1
            for (int j0 = 0; j0 < 256; j0 += 64) {
                float4 vv[16]; float pw[16];
#pragma unroll
                for (int q = 0; q < 16; ++q) { const int j = j0 + 4 * q + ks; const int rr = j < nsel ? prow[j] : -1; const bool ok = rr >= 0;
                    pw[q] = ok ? att[h * 256 + j] : 0.f;
                    vv[q] = *(const float4*)(cv + (size_t)(ok ? rr : 0) * 128 + n * 64 + 4 * d4); }
#pragma unroll
                for (int q = 0; q < 16; ++q) { o0 += pw[q] * vv[q].x; o1 += pw[q] * vv[q].y; o2 += pw[q] * vv[q].z; o3 += pw[q] * vv[q].w; }
            }
            if (ks == 0) {
#pragma unroll
                for (int tt = 0; tt < DEC_SEQ; ++tt) { const int jn = newslot[tt]; if (jn >= 0) { const float wn = att[h * 256 + jn]; const bf16_t* vp = Vb + (size_t)(RP + b * DEC_SEQ + tt) * 128 + n * 64 + 4 * d4;
                    o0 += wn * bf2f(vp[0]); o1 += wn * bf2f(vp[1]); o2 += wn * bf2f(vp[2]); o3 += wn * bf2f(vp[3]); } }
            }
            o0 += __shfl_xor(o0, 16); o1 += __shfl_xor(o1, 16); o2 += __shfl_xor(o2, 16); o3 += __shfl_xor(o3, 16);
            o0 += __shfl_xor(o0, 32); o1 += __shfl_xor(o1, 32); o2 += __shfl_xor(o2, 32); o3 += __shfl_xor(o3, 32);
            if (ks == 0) { const unsigned e = (unsigned)row * 512u + h * 64 + 4 * d4;
                YB[e] = (bf16_t)f2bf(o0 * LD(BG, e)); YB[e + 1] = (bf16_t)f2bf(o1 * LD(BG, e + 1)); YB[e + 2] = (bf16_t)f2bf(o2 * LD(BG, e + 2)); YB[e + 3] = (bf16_t)f2bf(o3 * LD(BG, e + 3)); }
        }
    }
}
constexpr int DSA_SC_OFF = 0, DSA_SEL_OFF = 65536, DSA_P_OFF = 65536 + 4096, DSA_H_OFF = 65536;
constexpr int DSA_GPI = 4;
__device__ __forceinline__ void dsa_prompt_item(KA a, const Ctx& c, int l, int b, int tq) {
    unsigned char* ws = a->ws; (void)l;
    const bf16_t* QI = (const bf16_t*)(ws + A_QI); const bf16_t* KI = (const bf16_t*)(ws + A_KI); const float* WI = (const float*)(ws + A_WI);
    LAS unsigned* SC = (LAS unsigned*)(c.lds_las + DSA_SC_OFF);
    const int lane = c.lane, c16 = lane & 15, g = lane >> 4;
    bf16x8_t Af[2][2]; float wq[2][4]; bf16x8_t B0[8], B1[8];
#define DSA_FETCH(tb_) do { const int t0_ = 8 * (tb_), row0_ = b * SEQ + t0_, ntiles_ = (t0_ + 8 + 15) >> 4; \
        _Pragma("unroll") for (int rt = 0; rt < 2; ++rt) { \
            _Pragma("unroll") for (int ks = 0; ks < 2; ++ks) Af[rt][ks] = *(const bf16x8_t*)(QI + ((unsigned)(row0_ + 4 * rt + (c16 >> 2)) * 256u + (c16 & 3) * 64 + 32 * ks + 8 * g)); \
            const f32x4 w4 = *(const f32x4*)(WI + (unsigned)(row0_ + 4 * rt + g) * 4u); wq[rt][0] = w4[0]; wq[rt][1] = w4[1]; wq[rt][2] = w4[2]; wq[rt][3] = w4[3]; } \
        _Pragma("unroll") for (int j = 0; j < 8; ++j) { const int nt0 = c.wave + 8 * j, nt = nt0 < ntiles_ ? nt0 : ntiles_ - 1; \
            const bf16_t* kp = KI + ((unsigned)(b * SEQ + 16 * nt + c16) * 64u + 8 * g); B0[j] = *(const bf16x8_t*)kp; B1[j] = *(const bf16x8_t*)(kp + 32); } } while (0)
#define DSA_SCORE(Bx0, Bx1, nt_) do { _Pragma("unroll") for (int rt = 0; rt < 2; ++rt) { \
            f32x4 acc = (f32x4){0.f, 0.f, 0.f, 0.f}; \
            acc = __builtin_amdgcn_mfma_f32_16x16x32_bf16(Af[rt][0], Bx0, acc, 0, 0, 0); acc = __builtin_amdgcn_mfma_f32_16x16x32_bf16(Af[rt][1], Bx1, acc, 0, 0, 0); \
            float sc = fmaxf(acc[0] * 0.125f, 0.f) * wq[rt][0]; \
            sc += fmaxf(acc[1] * 0.125f, 0.f) * wq[rt][1]; sc += fmaxf(acc[2] * 0.125f, 0.f) * wq[rt][2]; sc += fmaxf(acc[3] * 0.125f, 0.f) * wq[rt][3]; \
            SC[(4 * rt + g) * 2048 + 16 * (nt_) + c16] = fkey(sc * 0.5f); } } while (0)
    const int tb_hi = DSA_GPI * tq + DSA_GPI - 1;
    if (8 * tb_hi >= TOPK) DSA_FETCH(tb_hi);
#pragma unroll 1
    for (int tb = tb_hi; tb > tb_hi - DSA_GPI; --tb) {
    const int t0 = tb * 8, row0 = b * SEQ + t0;
    __syncthreads();
    if (t0 >= TOPK) {
        const int ntiles = (t0 + 8 + 15) >> 4;
#pragma unroll
        for (int j = 0; j < 8; ++j) { const int nt = c.wave + 8 * j; if (nt < ntiles) DSA_SCORE(B0[j], B1[j], nt); }
#pragma unroll 1
        for (int base = c.wave + 64; base < ntiles; base += 64) {
#pragma unroll
            for (int j = 0; j < 8; ++j) { const int nt0 = base + 8 * j, nt = nt0 < ntiles ? nt0 : ntiles - 1;
                const bf16_t* kp = KI + ((unsigned)(b * SEQ + 16 * nt + c16) * 64u + 8 * g); B0[j] = *(const bf16x8_t*)kp; B1[j] = *(const bf16x8_t*)(kp + 32); }
#pragma unroll
            for (int j = 0; j < 8; ++j) { const int nt = base + 8 * j; if (nt < ntiles) DSA_SCORE(B0[j], B1[j], nt); }
        }
    }
    __syncthreads();
    if (tb > tb_hi - DSA_GPI + 1 && t0 - 8 >= TOPK) DSA_FETCH(tb - 1);
        const int t = t0 + c.wave, nvalid = t + 1, row = row0 + c.wave;
        unsigned* selm = (unsigned*)(ws + A_SELM) + (unsigned)row * 64u;
        if (nvalid <= TOPK) {
            if (lane < 64) { const int w0 = 32 * lane; unsigned wd = 0u; if (w0 + 31 <= t) wd = 0xffffffffu; else if (w0 <= t) wd = (t - w0 == 31) ? 0xffffffffu : ((1u << (t - w0 + 1)) - 1u); selm[lane] = wd; }
        } else {
            const int ni = __builtin_amdgcn_readfirstlane((t >> 6) + 1), niq = (ni + 3) >> 2;
            LAS unsigned* SCw = SC + c.wave * 2048 + lane;
    #pragma unroll
            for (int j = 0; j < 4; ++j) { const int i = 4 * (niq - 1) + j; if (lane + 64 * i > t) SCw[64 * i] = 0u; }
            LAS unsigned* H = (LAS unsigned*)(c.lds_las + DSA_H_OFF) + c.wave * (8 * 260);
            LAS unsigned* Hc = H + (lane >> 3) * 260;
            unsigned prefix = 0u; int need = TOPK, lastcnt = 0;
    #pragma unroll 1
            for (int pass = 0; pass < 4; ++pass) {
                const int shift = 24 - 8 * pass; const unsigned himask = pass == 0 ? 0u : (0xffffffffu << (shift + 8));
                unsigned zz = 0u; asm volatile("" : "+v"(zz));
    #pragma unroll
                for (int cp = 0; cp < 8; ++cp) *(LAS u32x4*)(H + cp * 260 + 4 * lane) = (u32x4){zz, zz, zz, zz};
                if (pass == 0) {
    #pragma unroll 1
                    for (int iq = 0; iq < niq; ++iq) {
                        const unsigned k0 = SCw[256 * iq], k1 = SCw[256 * iq + 64], k2 = SCw[256 * iq + 128], k3 = SCw[256 * iq + 192];
                        (void)__hip_atomic_fetch_add(Hc + (k0 >> 24), 1u, __ATOMIC_RELAXED, __HIP_MEMORY_SCOPE_WORKGROUP); (void)__hip_atomic_fetch_add(Hc + (k1 >> 24), 1u, __ATOMIC_RELAXED, __HIP_MEMORY_SCOPE_WORKGROUP);
                        (void)__hip_atomic_fetch_add(Hc + (k2 >> 24), 1u, __ATOMIC_RELAXED, __HIP_MEMORY_SCOPE_WORKGROUP); (void)__hip_atomic_fetch_add(Hc + (k3 >> 24), 1u, __ATOMIC_RELAXED, __HIP_MEMORY_SCOPE_WORKGROUP);
                    }
                } else {
    #pragma unroll 1
                    for (int iq = 0; iq < niq; ++iq) {
                        const unsigned k0 = SCw[256 * iq], k1 = SCw[256 * iq + 64], k2 = SCw[256 * iq + 128], k3 = SCw[256 * iq + 192];
                        const bool h0 = (k0 & himask) == prefix, h1 = (k1 & himask) == prefix, h2 = (k2 & himask) == prefix, h3 = (k3 & himask) == prefix;
                        if (__ballot(h0 || h1 || h2 || h3) == 0ull) continue;
                        if (h0) (void)__hip_atomic_fetch_add(Hc + ((k0 >> shift) & 255u), 1u, __ATOMIC_RELAXED, __HIP_MEMORY_SCOPE_WORKGROUP);
                        if (h1) (void)__hip_atomic_fetch_add(Hc + ((k1 >> shift) & 255u), 1u, __ATOMIC_RELAXED, __HIP_MEMORY_SCOPE_WORKGROUP);
                        if (h2) (void)__hip_atomic_fetch_add(Hc + ((k2 >> shift) & 255u), 1u, __ATOMIC_RELAXED, __HIP_MEMORY_SCOPE_WORKGROUP);
                        if (h3) (void)__hip_atomic_fetch_add(Hc + ((k3 >> shift) & 255u), 1u, __ATOMIC_RELAXED, __HIP_MEMORY_SCOPE_WORKGROUP);
                    }
                }
                asm volatile("s_waitcnt lgkmcnt(0)" ::: "memory"); __builtin_amdgcn_wave_barrier();
                u32x4 hh[8];
    #pragma unroll
                for (int cp = 0; cp < 8; ++cp) hh[cp] = *(const LAS u32x4*)(H + cp * 260 + 4 * lane);
                asm volatile("s_waitcnt lgkmcnt(0)" ::: "memory");
                const u32x4 cnt = ((hh[0] + hh[1]) + (hh[2] + hh[3])) + ((hh[4] + hh[5]) + (hh[6] + hh[7]));
                const int ssum = (int)(cnt.x + cnt.y + cnt.z + cnt.w);
                int pre = ssum;
                pre += __builtin_amdgcn_update_dpp(0, pre, 0x111, 0xf, 0xf, false);
                pre += __builtin_amdgcn_update_dpp(0, pre, 0x112, 0xf, 0xf, false);
                pre += __builtin_amdgcn_update_dpp(0, pre, 0x114, 0xf, 0xf, false);
                pre += __builtin_amdgcn_update_dpp(0, pre, 0x118, 0xf, 0xf, false);
                pre += __builtin_amdgcn_update_dpp(0, pre, 0x142, 0xa, 0xf, false);
                pre += __builtin_amdgcn_update_dpp(0, pre, 0x143, 0xc, 0xf, false);
                const int total = __builtin_amdgcn_readlane(pre, 63);
                const int suf = total - pre + ssum;
                const unsigned long long m = __ballot(suf >= need);
                const int L = 63 - __clzll(m);
                const int above = L < 63 ? __builtin_amdgcn_readlane(suf, (L + 1) & 63) : 0;
                const int cx = __builtin_amdgcn_readlane((int)cnt.x, L), cy = __builtin_amdgcn_readlane((int)cnt.y, L), cz = __builtin_amdgcn_readlane((int)cnt.z, L), cw = __builtin_amdgcn_readlane((int)cnt.w, L);
                int q, ab;
                if (above + cw >= need) { q = 3; ab = above; lastcnt = cw; } else if (above + cw + cz >= need) { q = 2; ab = above + cw; lastcnt = cz; }
                else if (above + cw + cz + cy >= need) { q = 1; ab = above + cw + cz; lastcnt = cy; } else { q = 0; ab = above + cw + cz + cy; lastcnt = cx; }
                prefix |= (unsigned)(4 * L + q) << shift; need -= ab;
                if (need == lastcnt) break;
            }
            unsigned mylo = 0u, myhi = 0u;
            if (need == lastcnt && prefix != 0u) {
    #pragma unroll 1
                for (int iq = 0; iq < niq; ++iq) {
                    const unsigned k0 = SCw[256 * iq], k1 = SCw[256 * iq + 64], k2 = SCw[256 * iq + 128], k3 = SCw[256 * iq + 192];
                    const unsigned long long m0 = __ballot(k0 >= prefix), m1 = __ballot(k1 >= prefix), m2 = __ballot(k2 >= prefix), m3 = __ballot(k3 >= prefix);
                    const int i0 = 4 * iq;
                    if (lane == i0) { mylo = (unsigned)m0; myhi = (unsigned)(m0 >> 32); }
                    if (lane == i0 + 1) { mylo = (unsigned)m1; myhi = (unsigned)(m1 >> 32); }
                    if (lane == i0 + 2) { mylo = (unsigned)m2; myhi = (unsigned)(m2 >> 32); }
                    if (lane == i0 + 3) { mylo = (unsigned)m3; myhi = (unsigned)(m3 >> 32); }
                }
            } else {
                int ties_before = 0;
                const unsigned long long lt = (1ull << lane) - 1ull;
    #pragma unroll 1
                for (int i = 0; i < 4 * niq; ++i) {
                    const unsigned kk = SCw[64 * i];
                    const bool gt = kk > prefix, tie = kk == prefix;
                    const unsigned long long mt = __ballot(tie);
                    const bool take = gt || (tie && (ties_before + __popcll(mt & lt) < need));
                    const unsigned long long ms = __ballot(take);
                    if (lane == i) { mylo = (unsigned)ms; myhi = (unsigned)(ms >> 32); }
                    ties_before += __popcll(mt);
                }
            }
            if (lane < 32) *(u32x2*)(selm + 2 * lane) = (u32x2){mylo, myhi};
        }
    }
#undef DSA_FETCH
#undef DSA_SCORE
}
constexpr int HG_AQ = 0, HG_KT = HG_AQ + 32 * 272, HG_KHT = HG_KT + 32 * 272, HG_IT = HG_KHT + 128 * 80, HG_ATT = HG_IT + 128 * 80, HG_TOT = HG_ATT + 32 * 80, HG_EB = HG_TOT + 2048, HG_PART = HG_EB + 512;
__device__ __forceinline__ bf16x8_t ld_perm_frag(const LAS bf16_t* rowp, int ks, int g) {
    const u32x2 lo = *(const LAS u32x2*)(rowp + 32 * ks + 4 * g), hi = *(const LAS u32x2*)(rowp + 32 * ks + 16 + 4 * g);
    const u32x4 w = (u32x4){lo.x, lo.y, hi.x, hi.y}; return __builtin_bit_cast(bf16x8_t, w);
}
#define HG_STORE_CHUNK(nn) do { _Pragma("unroll") for (int tt = 0; tt < 2; ++tt) _Pragma("unroll") for (int r = 0; r < 4; ++r) { const int t = 16 * tt + 4 * g + r; const float tot = PART[((nn) & 1) * 32 + t]; \
        const unsigned e = (row0 + 32u * (nn) + t) * 512u + hc + 16 * w + c16; \
        YC[e] = (bf16_t)f2bf(o[tt][r] * rsqrtf(tot * (1.f / 128.f) + EPS) * cgv * bf2f((bf16_t)cgl[4 * tt + r])); } } while (0)
template <int TT, int ST>
__device__ __forceinline__ void hgrn_att_tile(const bf16x8_t (&A)[4], const LAS bf16_t* Kt, LAS bf16_t* ATT, int c16, int g) {
    f32x4 acc = (f32x4){0.f, 0.f, 0.f, 0.f};
#pragma unroll
    for (int ks = 0; ks < 4; ++ks) { const bf16x8_t Bk = ld_perm_frag(Kt + (16 * ST + c16) * 136, ks, g); acc = __builtin_amdgcn_mfma_f32_16x16x32_bf16(A[ks], Bk, acc, 0, 0, 0); }
#pragma unroll
    for (int r = 0; r < 4; ++r) { const float v = (TT != ST || c16 <= 4 * g + r) ? acc[r] : 0.f; ATT[(16 * TT + 4 * g + r) * 40 + 16 * ST + c16] = (bf16_t)f2bf(v); }
}
__device__ __forceinline__ void hgrn_prompt_item(KA a, const Ctx& c, int l, int b, int h, int n0, int n1) {
    unsigned char* ws = a->ws;
    const bf16_t* CQ = (const bf16_t*)(ws + A_CQ); const float* LF = (const float*)(ws + A_LF); const bf16_t* KK = (const bf16_t*)(ws + A_KK);
    const bf16_t* CI = (const bf16_t*)(ws + A_CI); const bf16_t* CG = (const bf16_t*)(ws + A_CG); bf16_t* YC = (bf16_t*)(ws + A_YC);
    const float* cg = a->c_norm_g + l * C_VDIM;
    LAS bf16_t* Aq = (LAS bf16_t*)(c.lds_las + HG_AQ); LAS bf16_t* Kt = (LAS bf16_t*)(c.lds_las + HG_KT); LAS bf16_t* KhT = (LAS bf16_t*)(c.lds_las + HG_KHT);
    LAS bf16_t* IT = (LAS bf16_t*)(c.lds_las + HG_IT); LAS bf16_t* ATT = (LAS bf16_t*)(c.lds_las + HG_ATT); LAS float* TOT = (LAS float*)(c.lds_las + HG_TOT);
    LAS float* EB = (LAS float*)(c.lds_las + HG_EB); LAS float* PART = (LAS float*)(c.lds_las + HG_PART);
    const int tid = c.tid, lane = c.lane, w = c.wave, c16 = lane & 15, g = lane >> 4, d = tid & 127, tq = tid >> 7;
    const unsigned hc = (unsigned)h * 128u, row0 = (unsigned)b * SEQ;
    f32x4 S[8];
    float* so = a->out + O_HGP + (((size_t)l * BATCH + b) * C_HEADS + h) * C_KDIM * C_VDIM;
#pragma unroll
    for (int dt = 0; dt < 8; ++dt) {
        S[dt] = (f32x4){0.f, 0.f, 0.f, 0.f};
        if (n0 > 0) {
#pragma unroll
            for (int r = 0; r < 4; ++r) S[dt][r] = so[(16 * dt + 4 * g + r) * C_VDIM + 16 * w + c16];
        } }
    const float cgv = cg[16 * w + c16];
    f32x4 o[2] = {(f32x4){0.f, 0.f, 0.f, 0.f}, (f32x4){0.f, 0.f, 0.f, 0.f}};
    float nlf[8]; unsigned nq[8], nk[8], ni[8]; unsigned cgl[8];
#pragma unroll
    for (int i = 0; i < 8; ++i) { const unsigned e = (row0 + 32u * n0 + 8u * tq + i) * 512u + hc + d; nlf[i] = LF[e]; nq[i] = CQ[e]; nk[i] = KK[e]; ni[i] = CI[e]; }
    __syncthreads();
#pragma unroll 1
    for (int n = n0; n < n1; ++n) {
        float lf[8], qv[8], kv[8]; unsigned iv[8];
#pragma unroll
        for (int i = 0; i < 8; ++i) { lf[i] = nlf[i]; qv[i] = bf2f((bf16_t)nq[i]); kv[i] = bf2f((bf16_t)nk[i]); iv[i] = ni[i]; }
        float run = 0.f;
#pragma unroll
        for (int i = 0; i < 8; ++i) { run += lf[i]; lf[i] = run; }
        TOT[tq * 128 + d] = run;
        asm volatile("s_waitcnt lgkmcnt(0)" ::: "memory"); __syncthreads();
        if (n > n0) HG_STORE_CHUNK(n - 1);
        const float t0 = TOT[d], t1 = TOT[128 + d], t2 = TOT[256 + d], t3 = TOT[384 + d];
        const float off = (tq > 0 ? t0 : 0.f) + (tq > 1 ? t1 : 0.f) + (tq > 2 ? t2 : 0.f), bend = (t0 + t1) + (t2 + t3);
        unsigned khp[4], itp[4]; const float ebend = __expf(bend);
#pragma unroll
        for (int i = 0; i < 8; i += 2) {
            const float b0 = off + lf[i], b1 = off + lf[i + 1];
            const float a0 = qv[i] * __expf(b0), a1 = qv[i + 1] * __expf(b1);
            const float k0 = kv[i] * __expf(fminf(-b0, 80.f)), k1 = kv[i + 1] * __expf(fminf(-b1, 80.f));
            Aq[(8 * tq + i) * 136 + d] = (bf16_t)f2bf(a0); Aq[(8 * tq + i + 1) * 136 + d] = (bf16_t)f2bf(a1);
            Kt[(8 * tq + i) * 136 + d] = (bf16_t)f2bf(k0); Kt[(8 * tq + i + 1) * 136 + d] = (bf16_t)f2bf(k1);
            khp[i >> 1] = pk2(k0 * ebend, k1 * ebend);
            itp[i >> 1] = iv[i] | (iv[i + 1] << 16);
        }
        *(LAS u32x4*)(KhT + d * 40 + 8 * tq) = (u32x4){khp[0], khp[1], khp[2], khp[3]};
        *(LAS u32x4*)(IT + d * 40 + 8 * tq) = (u32x4){itp[0], itp[1], itp[2], itp[3]};
        if (tq == 0) EB[d] = ebend;
        if (tid < 32) PART[(n & 1) * 32 + tid] = 0.f;
#pragma unroll
        for (int tt = 0; tt < 2; ++tt)
#pragma unroll
            for (int r = 0; r < 4; ++r) cgl[4 * tt + r] = CG[(row0 + 32u * n + 16 * tt + 4 * g + r) * 512u + hc + 16 * w + c16];
        if (n + 1 < n1) {
#pragma unroll
            for (int i = 0; i < 8; ++i) { const unsigned e = (row0 + 32u * (n + 1) + 8u * tq + i) * 512u + hc + d; nlf[i] = LF[e]; nq[i] = CQ[e]; nk[i] = KK[e]; ni[i] = CI[e]; }
        }
        asm volatile("s_waitcnt lgkmcnt(0)" ::: "memory"); __syncthreads();
        bf16x8_t Af[2][4];
#pragma unroll
        for (int tt = 0; tt < 2; ++tt)
#pragma unroll
            for (int ks = 0; ks < 4; ++ks) Af[tt][ks] = ld_perm_frag(Aq + (16 * tt + c16) * 136, ks, g);
        if (w == 0) hgrn_att_tile<0, 0>(Af[0], Kt, ATT, c16, g);
        else if (w == 1) hgrn_att_tile<1, 0>(Af[1], Kt, ATT, c16, g);
        else if (w == 2) hgrn_att_tile<1, 1>(Af[1], Kt, ATT, c16, g);
        else if (w == 3) {
#pragma unroll
            for (int r = 0; r < 4; ++r) ATT[(4 * g + r) * 40 + 16 + c16] = (bf16_t)0;
        }
        o[0] = (f32x4){0.f, 0.f, 0.f, 0.f}; o[1] = (f32x4){0.f, 0.f, 0.f, 0.f};
#pragma unroll
        for (int ks = 0; ks < 4; ++ks) {
            const u32x4 bw = (u32x4){pk2(S[2 * ks][0], S[2 * ks][1]), pk2(S[2 * ks][2], S[2 * ks][3]), pk2(S[2 * ks + 1][0], S[2 * ks + 1][1]), pk2(S[2 * ks + 1][2], S[2 * ks + 1][3])};
            const bf16x8_t Bs = __builtin_bit_cast(bf16x8_t, bw);
            o[0] = __builtin_amdgcn_mfma_f32_16x16x32_bf16(Af[0][ks], Bs, o[0], 0, 0, 0);
            o[1] = __builtin_amdgcn_mfma_f32_16x16x32_bf16(Af[1][ks], Bs, o[1], 0, 0, 0);
        }
        const bf16x8_t Bi = *(const LAS bf16x8_t*)(IT + (16 * w + c16) * 40 + 8 * g);
#pragma unroll
        for (int dt = 0; dt < 8; ++dt) { const bf16x8_t Ak = *(const LAS bf16x8_t*)(KhT + (16 * dt + c16) * 40 + 8 * g); const f32x4 eb4 = *(const LAS f32x4*)(EB + 16 * dt + 4 * g);
            S[dt] = __builtin_amdgcn_mfma_f32_16x16x32_bf16(Ak, Bi, S[dt] * eb4, 0, 0, 0); }
        asm volatile("s_waitcnt lgkmcnt(0)" ::: "memory"); __syncthreads();
#pragma unroll
        for (int tt = 0; tt < 2; ++tt) { const bf16x8_t Aa = *(const LAS bf16x8_t*)(ATT + (16 * tt + c16) * 40 + 8 * g); o[tt] = __builtin_amdgcn_mfma_f32_16x16x32_bf16(Aa, Bi, o[tt], 0, 0, 0); }
#pragma unroll
        for (int tt = 0; tt < 2; ++tt)
#pragma unroll
            for (int r = 0; r < 4; ++r) { float ss = o[tt][r] * o[tt][r];
                ss += __builtin_bit_cast(float, __builtin_amdgcn_update_dpp(0, __builtin_bit_cast(int, ss), 0x111, 0xf, 0xf, false));
                ss += __builtin_bit_cast(float, __builtin_amdgcn_update_dpp(0, __builtin_bit_cast(int, ss), 0x112, 0xf, 0xf, false));
                ss += __builtin_bit_cast(float, __builtin_amdgcn_update_dpp(0, __builtin_bit_cast(int, ss), 0x114, 0xf, 0xf, false));
                ss += __builtin_bit_cast(float, __builtin_amdgcn_update_dpp(0, __builtin_bit_cast(int, ss), 0x118, 0xf, 0xf, false));
                if (c16 == 15) atomicAdd((float*)(PART + (n & 1) * 32 + 16 * tt + 4 * g + r), ss); }
    }
    asm volatile("s_waitcnt lgkmcnt(0)" ::: "memory"); __syncthreads();
    HG_STORE_CHUNK(n1 - 1);
#pragma unroll
    for (int dt = 0; dt < 8; ++dt)
#pragma unroll
        for (int r = 0; r < 4; ++r) so[(16 * dt + 4 * g + r) * C_VDIM + 16 * w + c16] = S[dt][r];
}
__device__ __forceinline__ void mix_hgrn_prompt(KA a, const Ctx& c, int l) {
    for (int it = c.bid; it < BATCH * C_HEADS; it += c.nblk) { hgrn_prompt_item(a, c, l, it / C_HEADS, it % C_HEADS, 0, 64); }
}
__device__ __forceinline__ bool hgrn_is_early(KA a, const Ctx& c) { return c.nblk == 256 && a->use_bar != 0; }
__device__ __forceinline__ void hgrn_early(KA a, const Ctx& c, int l) {
    if (!hgrn_is_early(a, c) || c.bid < 224) return;
    unsigned* ctr = (unsigned*)(a->ws + WS_CTL) + CW_HGE + 64 * l;
    __syncthreads();
    if (c.tid == 0) { unsigned sp = 0u; while (__hip_atomic_load(ctr, __ATOMIC_RELAXED, __HIP_MEMORY_SCOPE_AGENT) < 256u) { __builtin_amdgcn_s_sleep(2); if (++sp > (1u << 22)) break; }
        __builtin_amdgcn_fence(__ATOMIC_ACQUIRE, "agent"); asm volatile("s_waitcnt vmcnt(0)" ::: "memory"); }
    __syncthreads();
    hgrn_prompt_item(a, c, l, (c.bid - 224) >> 2, (c.bid - 224) & 3, 0, HG_EARLY);
}

template <bool SAMPLE>
__device__ __forceinline__ void conv_item(KA a, const Ctx& c, int l, int b, int tt) {
    unsigned char* ws = a->ws;
    const bf16_t* U = (const bf16_t*)(ws + A_U); const bf16_t* AG = (const bf16_t*)(ws + A_AG); bf16_t* YA = (bf16_t*)(ws + A_YA);
    const float* wdw = a->w_dw + (size_t)l * CONV_W * D_A;
    LAS float* Y = (LAS float*)c.lds_las;
    constexpr int NTOK = SAMPLE ? DEC_SEQ : 32, NWIN = NTOK + 30;
    const int ch = c.tid; const int t0 = SAMPLE ? 0 : 32 * tt; const unsigned rowb = SAMPLE ? (unsigned)(RP + b * DEC_SEQ) : (unsigned)(b * SEQ + t0);
    constexpr int NTW = (NTOK + 7) / 8;
    u32x4 agr[NTW]; float g8[8], b8[8];
    { const float* lg = a->ln_g + l * D_A + 8 * c.lane; const float* lb = a->ln_b + l * D_A + 8 * c.lane; ld8(lg, g8); ld8(lb, b8); }
#pragma unroll
    for (int i = 0; i < NTW; ++i) { const int t = c.wave + 8 * i, tc = t < NTOK ? t : NTOK - 1; agr[i] = *(const u32x4*)(AG + (rowb + tc) * 512u + 8 * c.lane); }
    __syncthreads();
    {
        float win[NWIN];
        if (SAMPLE) {
            const float* buf = a->state_conv + ((size_t)l * DEC_BATCH + b) * 30 * D_A;
#pragma unroll
            for (int i = 0; i < 30; ++i) win[i] = buf[i * D_A + ch];
#pragma unroll
            for (int i = 0; i < DEC_SEQ; ++i) win[30 + i] = bf2f(U[(rowb + i) * 512u + ch]);
            float* so = a->out + O_CVS + ((size_t)l * DEC_BATCH + b) * 30 * D_A;
#pragma unroll
            for (int j = 0; j < 26; ++j) so[j * D_A + ch] = win[j + DEC_SEQ];
        } else {
#pragma unroll
            for (int i = 0; i < NWIN; ++i) { const int t = t0 - 30 + i; const int tc = t >= 0 ? t : 0;
                const float uv = bf2f(U[(unsigned)(b * SEQ + tc) * 512u + ch]); win[i] = t >= 0 ? uv : 0.f; }
        }
        float y[NTOK]; const float bias = a->b_dw[l * D_A + ch];
#pragma unroll
        for (int t = 0; t < NTOK; ++t) y[t] = bias;
        float wj[CONV_W];
#pragma unroll
        for (int j = 0; j < CONV_W; ++j) wj[j] = wdw[j * D_A + ch];
#pragma unroll
        for (int j = 0; j < CONV_W; ++j) {
#pragma unroll
            for (int t = 0; t < NTOK; ++t) y[t] += wj[j] * win[t + j]; }
#pragma unroll
        for (int t = 0; t < NTOK; ++t) Y[t * 512 + ch] = y[t];
    }
    asm volatile("s_waitcnt lgkmcnt(0)" ::: "memory"); __syncthreads();
    {
        const int lane = c.lane;
#pragma unroll
        for (int i = 0; i < NTW; ++i) { const int t = c.wave + 8 * i; if (t < NTOK) {
            float v[8]; { const f32x4 v0 = *(const LAS f32x4*)(Y + t * 512 + 8 * lane), v1 = *(const LAS f32x4*)(Y + t * 512 + 8 * lane + 4); v[0] = v0[0]; v[1] = v0[1]; v[2] = v0[2]; v[3] = v0[3]; v[4] = v1[0]; v[5] = v1[1]; v[6] = v1[2]; v[7] = v1[3]; }
            float s = 0.f;
#pragma unroll
            for (int e = 0; e < 8; ++e) s += v[e];
            const float mu = wave_sum(s) * (1.f / D_A); float q = 0.f;
#pragma unroll
            for (int e = 0; e < 8; ++e) { v[e] -= mu; q += v[e] * v[e]; }
            const float rstd = rsqrtf(wave_sum(q) * (1.f / D_A) + EPS);
            const unsigned o = (rowb + t) * 512u + 8 * lane; float ag[8]; { const u32x4 w_ = agr[i]; ag[0] = __uint_as_float(w_.x << 16); ag[1] = __uint_as_float(w_.x & 0xffff0000u); ag[2] = __uint_as_float(w_.y << 16); ag[3] = __uint_as_float(w_.y & 0xffff0000u); ag[4] = __uint_as_float(w_.z << 16); ag[5] = __uint_as_float(w_.z & 0xffff0000u); ag[6] = __uint_as_float(w_.w << 16); ag[7] = __uint_as_float(w_.w & 0xffff0000u); }
            float r[8];
#pragma unroll
            for (int e = 0; e < 8; ++e) { const float ln = v[e] * rstd * g8[e] + b8[e]; r[e] = ln * fsig(ln) * ag[e]; }
            u32x4 w; w.x = pk2(r[0], r[1]); w.y = pk2(r[2], r[3]); w.z = pk2(r[4], r[5]); w.w = pk2(r[6], r[7]);
            *(u32x4*)(YA + o) = w;
        } }
    }
}

constexpr int DA_KT = 0, DA_VT = DA_KT + 2 * 9216, DA_TILE = 9216;
__device__ __forceinline__ void da_compute(const LAS bf16_t* KT, const LAS bf16_t* VTl, const unsigned (&mw)[2][2], const bf16x8_t (&Bq)[2][2], f32x4 (&O)[2][4], float (&lsum)[2], int c16, int g) {
#pragma unroll
    for (int sub = 0; sub < 2; ++sub) {
        f32x4 sc[2][2];
#pragma unroll
        for (int nt = 0; nt < 2; ++nt) {
            const LAS bf16_t* kp = KT + (32 * sub + 16 * nt + c16) * 72 + 8 * g;
            const bf16x8_t A0 = *(const LAS bf16x8_t*)kp, A1 = *(const LAS bf16x8_t*)(kp + 32);
            __builtin_amdgcn_s_setprio(1);
#pragma unroll
            for (int j = 0; j < 2; ++j) {
                f32x4 acc = (f32x4){0.f, 0.f, 0.f, 0.f};
                acc = __builtin_amdgcn_mfma_f32_16x16x32_bf16(A0, Bq[j][0], acc, 0, 0, 0);
                sc[j][nt] = __builtin_amdgcn_mfma_f32_16x16x32_bf16(A1, Bq[j][1], acc, 0, 0, 0);
            }
            __builtin_amdgcn_s_setprio(0);
        }
        bf16x8_t Bp[2];
#pragma unroll
        for (int j = 0; j < 2; ++j) {
            const unsigned bits = mw[j][sub] >> (4 * g);
            float p[8];
#pragma unroll
            for (int nt = 0; nt < 2; ++nt)
#pragma unroll
                for (int r = 0; r < 4; ++r) { const float e = __builtin_amdgcn_exp2f(sc[j][nt][r] * (0.125f * 1.4426950408889634f)); p[4 * nt + r] = ((bits >> (16 * nt + r)) & 1u) ? e : 0.f; }
            lsum[j] += ((p[0] + p[1]) + (p[2] + p[3])) + ((p[4] + p[5]) + (p[6] + p[7]));
            const u32x4 pw = (u32x4){pg8::cvt_pk_bf16(p[0], p[1]), pg8::cvt_pk_bf16(p[2], p[3]), pg8::cvt_pk_bf16(p[4], p[5]), pg8::cvt_pk_bf16(p[6], p[7])};
            Bp[j] = __builtin_bit_cast(bf16x8_t, pw);
        }
#pragma unroll
        for (int dt = 0; dt < 4; ++dt) {
            const LAS bf16_t* vp = VTl + (16 * dt + c16) * 72 + 32 * sub + 4 * g;
            const u32x2 lo = *(const LAS u32x2*)vp, hi = *(const LAS u32x2*)(vp + 16);
            const u32x4 vw = (u32x4){lo.x, lo.y, hi.x, hi.y}; const bf16x8_t Av = __builtin_bit_cast(bf16x8_t, vw);
            __builtin_amdgcn_s_setprio(1);
            O[0][dt] = __builtin_amdgcn_mfma_f32_16x16x32_bf16(Av, Bp[0], O[0][dt], 0, 0, 0);
            O[1][dt] = __builtin_amdgcn_mfma_f32_16x16x32_bf16(Av, Bp[1], O[1][dt], 0, 0, 0);
            __builtin_amdgcn_s_setprio(0);
        }
    }
}
__device__ __forceinline__ void dense_attn_item(KA a, const Ctx& c, int l, int b, int n, int q2) {
    unsigned char* ws = a->ws; (void)l;
    const bf16_t* Q = (const bf16_t*)(ws + A_Q); const bf16_t* Kb = (const bf16_t*)(ws + A_K); const bf16_t* VT = (const bf16_t*)(ws + A_VT);
    const unsigned* selm = (const unsigned*)(ws + A_SELM); const bf16_t* BG = (const bf16_t*)(ws + A_BG); bf16_t* YB = (bf16_t*)(ws + A_YB);
    const int tid = c.tid, lane = c.lane, w = c.wave, c16 = lane & 15, g = lane >> 4, t0 = 64 * q2;
    const unsigned qrow0 = (unsigned)(b * SEQ + t0 + 8 * w + (c16 >> 2));
    bf16x8_t Bq[2][2];
#pragma unroll
    for (int j = 0; j < 2; ++j)
#pragma unroll
        for (int ks = 0; ks < 2; ++ks) Bq[j][ks] = *(const bf16x8_t*)(Q + ((qrow0 + 4 * j) * 512u + (4 * n + (c16 & 3)) * 64 + 32 * ks + 8 * g));
    const unsigned* mrow0 = selm + qrow0 * 64u; const unsigned* mrow1 = mrow0 + 4 * 64;
    const int trow = tid >> 3, tch = tid & 7;
    const bf16_t* kg = Kb + ((unsigned)(b * SEQ + trow) * 128u + n * 64 + 8 * tch);
    const bf16_t* vg = VT + ((unsigned)((b * 2 + n) * 64 + trow) * (unsigned)SEQ + 8 * tch);
    const int lds_off = trow * 72 + 8 * tch;
    f32x4 O[2][4];
#pragma unroll
    for (int j = 0; j < 2; ++j)
#pragma unroll
        for (int dt = 0; dt < 4; ++dt) O[j][dt] = (f32x4){0.f, 0.f, 0.f, 0.f};
    float lsum[2] = {0.f, 0.f};
    const int M = q2 + 1;
    LAS bf16_t* KT0 = (LAS bf16_t*)(c.lds_las + DA_KT); LAS bf16_t* KT1 = (LAS bf16_t*)(c.lds_las + DA_KT + DA_TILE);
    LAS bf16_t* VT0 = (LAS bf16_t*)(c.lds_las + DA_VT); LAS bf16_t* VT1 = (LAS bf16_t*)(c.lds_las + DA_VT + DA_TILE);
    const int Mp = (M + 1) & ~1;
#define DA_TILE_LD(rk_, rv_, m_) do { const int mc_ = (m_) < M ? (m_) : M - 1; rk_ = *(const u32x4*)(kg + (unsigned)(64 * mc_) * 128u); rv_ = *(const u32x4*)(vg + 64 * mc_); } while (0)
#define DA_MW_LD(dst_, m_) do { const int s0_ = 2 * (m_) < 64 ? 2 * (m_) : 62; const u32x2 x0_ = *(const u32x2*)(mrow0 + s0_), x1_ = *(const u32x2*)(mrow1 + s0_); \
        dst_[0][0] = x0_.x; dst_[0][1] = x0_.y; dst_[1][0] = x1_.x; dst_[1][1] = x1_.y; } while (0)
    u32x4 rkA, rvA, rkB, rvB;
    { u32x4 rk0, rv0; DA_TILE_LD(rk0, rv0, 0); *(LAS u32x4*)(KT0 + lds_off) = rk0; *(LAS u32x4*)(VT0 + lds_off) = rv0; }
    DA_TILE_LD(rkA, rvA, 1); DA_TILE_LD(rkB, rvB, 2);
    unsigned mw0[2][2], mw1[2][2];
    DA_MW_LD(mw0, 0); DA_MW_LD(mw1, 1);
    asm volatile("s_waitcnt lgkmcnt(0)" ::: "memory"); __syncthreads();
#pragma unroll 1
    for (int m = 0; m < Mp; m += 2) {
        unsigned nw0[2][2], nw1[2][2];
        DA_MW_LD(nw0, m + 2);
        da_compute(KT0, VT0, mw0, Bq, O, lsum, c16, g);
        *(LAS u32x4*)(KT1 + lds_off) = rkA; *(LAS u32x4*)(VT1 + lds_off) = rvA;
        DA_TILE_LD(rkA, rvA, m + 3);
        asm volatile("s_waitcnt lgkmcnt(0)" ::: "memory"); __syncthreads();
        DA_MW_LD(nw1, m + 3);
        da_compute(KT1, VT1, mw1, Bq, O, lsum, c16, g);
        *(LAS u32x4*)(KT0 + lds_off) = rkB; *(LAS u32x4*)(VT0 + lds_off) = rvB;
        DA_TILE_LD(rkB, rvB, m + 4);
        asm volatile("s_waitcnt lgkmcnt(0)" ::: "memory"); __syncthreads();
#pragma unroll
        for (int j = 0; j < 2; ++j) { mw0[j][0] = nw0[j][0]; mw0[j][1] = nw0[j][1]; mw1[j][0] = nw1[j][0]; mw1[j][1] = nw1[j][1]; }
    }
#undef DA_TILE_LD
#undef DA_MW_LD
#pragma unroll
    for (int j = 0; j < 2; ++j) {
        float ls = lsum[j]; ls += __shfl_xor(ls, 16); ls += __shfl_xor(ls, 32);
        const float inv = 1.f / ls;
#pragma unroll
        for (int dt = 0; dt < 4; ++dt) {
            const unsigned e = (qrow0 + 4 * j) * 512u + (4 * n + (c16 & 3)) * 64 + 16 * dt + 4 * g;
            const u32x2 gw = *(const u32x2*)(BG + e);
            const float g0 = __uint_as_float(gw.x << 16), g1 = __uint_as_float(gw.x & 0xffff0000u), g2 = __uint_as_float(gw.y << 16), g3 = __uint_as_float(gw.y & 0xffff0000u);
            *(u32x2*)(YB + e) = (u32x2){pk2(O[j][dt][0] * inv * g0, O[j][dt][1] * inv * g1), pk2(O[j][dt][2] * inv * g2, O[j][dt][3] * inv * g3)};
        }
    }
}
constexpr int CW_QUEUE = 8192;
constexpr int Q_SDSA = DEC_BATCH * DEC_SEQ  , Q_PDSA = BATCH * 256  , Q_CONV = BATCH * (SEQ / 32)  , Q_SCONV = DEC_BATCH, Q_SHGRN = DEC_BATCH * C_HEADS;
constexpr int Q_TOTAL = Q_SDSA + Q_PDSA + Q_CONV + Q_SCONV + Q_SHGRN;
constexpr int QX_TOTAL = 4 + 16 / DSA_TPI + 256 / DSA_GPI + 64 + 4 + 16;
__device__ __forceinline__ int q_next(unsigned* ctr, const Ctx& c) {
    LAS int* slot = (LAS int*)(c.lds_las + (LDS_BYTES - 128));
    __syncthreads();
    if (c.tid == 0) *slot = (int)__hip_atomic_fetch_add(ctr, 1u, __ATOMIC_RELAXED, __HIP_MEMORY_SCOPE_AGENT);
    __syncthreads();
    return *slot;
}

__device__ __forceinline__ unsigned q_live(unsigned* ctr0, unsigned limit, const Ctx& c) {
    LAS unsigned* slot = (LAS unsigned*)(c.lds_las + (LDS_BYTES - 128 + 16));
    __syncthreads();
    if (c.tid < 64) { unsigned v = limit; if (c.tid < 8) v = __hip_atomic_load(ctr0 + 64 * c.tid, __ATOMIC_RELAXED, __HIP_MEMORY_SCOPE_AGENT);
        const unsigned long long m = __ballot(v < limit); if (c.tid == 0) *slot = (unsigned)m; }
    __syncthreads();
    return (unsigned)__builtin_amdgcn_readfirstlane((int)*slot);
}
__device__ __forceinline__ void mix_all(KA a, const Ctx& c0, int l0) {
    Ctx c = c0; int l = l0;
    const int xcc = (int)(xb_xcc_id() & 7u);
    unsigned live = 0xffu;
#pragma unroll 1
    for (int qi = 0; qi < 8; ++qi) {
        const int bq = (xcc + qi) & 7;
        if (qi > 0) { if (qi == 1 || ((live >> bq) & 1u)) live = q_live((unsigned*)(a->ws + WS_CTL) + CW_QUEUE + 64 * (l * 8), QX_TOTAL, c); if (live == 0u) break; if (!((live >> bq) & 1u)) continue; }
        for (;;) {
            asm volatile("" : "+v"(c.tid), "+v"(c.lane));
            unsigned* ctr = (unsigned*)(a->ws + WS_CTL) + CW_QUEUE + 64 * (l * 8 + bq);
            int it = q_next(ctr, c);
            if (it >= QX_TOTAL) break;
            if (it < 4) { hgrn_prompt_item(a, c, l, bq, it, hgrn_is_early(a, c) ? HG_EARLY : 0, 64); continue; } it -= 4;
            if (it < 16 / DSA_TPI) { mix_dsa4(a, c, l, 4 * bq + it / (DEC_SEQ / DSA_TPI), it % (DEC_SEQ / DSA_TPI)); continue; } it -= 16 / DSA_TPI;
            if (it < 32) { dsa_prompt_item(a, c, l, bq, 256 / DSA_GPI - 1 - it); continue; } it -= 32;
            if (it < 64) { conv_item<false>(a, c, l, bq, it); continue; } it -= 64;
            if (it < 4) { conv_item<true>(a, c, l, 4 * bq + it, 0); continue; } it -= 4;
            if (it < 16) { const int item = BATCH * C_HEADS + 16 * bq + it; mix_hgrn(a, c, l, item, item + 1); continue; } it -= 16;
            dsa_prompt_item(a, c, l, bq, 256 / DSA_GPI - 1 - 32 - it);
        }
    }
}

__device__ __forceinline__ void sample_proj_slab(KA a, const Ctx& c, int l, int ct);
__device__ __forceinline__ void phase_attn(KA a, const Ctx& c0, int l) {
    Ctx c = c0;
    const int xcc = (int)(xb_xcc_id() & 7u);
    unsigned live = 0xffu;
#pragma unroll 1
    for (int qi = 0; qi < 8; ++qi) {
        const int bq = (xcc + qi) & 7;
        if (qi > 0) { if (qi == 1 || ((live >> bq) & 1u)) live = q_live((unsigned*)(a->ws + WS_CTL) + CW_QUEUE + 64 * (16 + l * 8), 72u, c); if (live == 0u) break; if (!((live >> bq) & 1u)) continue; }
        for (;;) {
            asm volatile("" : "+v"(c.tid), "+v"(c.lane));
            unsigned* ctr = (unsigned*)(a->ws + WS_CTL) + CW_QUEUE + 64 * (16 + l * 8 + bq);
            int it = q_next(ctr, c);
            if (it >= 72) break;
            if (it >= 64) { sample_proj_slab(a, c, l, 8 * bq + (it - 64)); continue; }
            dense_attn_item(a, c, l, bq, it & 1, 31 - (it >> 1));
        }
    }
}

template <int K>
__device__ __forceinline__ f32x4 sample_dot(const bf16_t* Arow, const bf16_t* Brow, int g) {
    f32x4 acc = (f32x4){0.f, 0.f, 0.f, 0.f};
#pragma unroll 8
    for (int ks = 0; ks < K / 32; ++ks) {
        const bf16x8_t A = *(const bf16x8_t*)(Arow + 32 * ks + 8 * g), B = *(const bf16x8_t*)(Brow + 32 * ks + 8 * g);
        acc = __builtin_amdgcn_mfma_f32_16x16x32_bf16(A, B, acc, 0, 0, 0);
    }
    return acc;
}
__device__ __forceinline__ void sample_proj_slab(KA a, const Ctx& c, int l, int ct) {
    unsigned char* ws = a->ws; const int c16 = c.lane & 15, g = c.lane >> 4, w = c.wave;
    {
        const unsigned arow = (unsigned)(RP + 16 * w + c16), bcol = (unsigned)(16 * ct + c16);
        const f32x4 pa = sample_dot<512>((const bf16_t*)(ws + A_YA) + arow * 512u, (const bf16_t*)(ws + WS_WTPA) + (size_t)l * 1024 * 512 + bcol * 512u, g);
        const f32x4 pb = sample_dot<512>((const bf16_t*)(ws + A_YB) + arow * 512u, (const bf16_t*)(ws + WS_WTPB) + (size_t)l * 1024 * 512 + bcol * 512u, g);
        const f32x4 pc = sample_dot<512>((const bf16_t*)(ws + A_YC) + arow * 512u, (const bf16_t*)(ws + WS_WTPC) + (size_t)l * 1024 * 512 + bcol * 512u, g);
        bf16_t* Mb = (bf16_t*)(ws + A_M);
#pragma unroll
        for (int r = 0; r < 4; ++r) { const unsigned o = (unsigned)(RP + 16 * w + 4 * g + r) * 1024u + bcol;
            const float m = bf2f(((const bf16_t*)(ws + A_GA))[o]) * pa[r] + bf2f(((const bf16_t*)(ws + A_GB))[o]) * pb[r] + bf2f(((const bf16_t*)(ws + A_GC))[o]) * pc[r];
            Mb[o] = (bf16_t)f2bf(m); }
    }
}
__device__ __forceinline__ void sample_out(KA a, const Ctx& c, int l, const float* xin_s, float* yout_s) {
    unsigned char* ws = a->ws; const int c16 = c.lane & 15, g = c.lane >> 4, w = c.wave;
    const float* mod = (const float*)(ws + WS_MOD) + (size_t)l * 40 * 3072 + 2048;
    for (int ct = c.bid; ct < 64; ct += c.nblk) {
        const unsigned arow = (unsigned)(RP + 16 * w + c16), bcol = (unsigned)(16 * ct + c16);
        const f32x4 acc = sample_dot<1024>((const bf16_t*)(ws + A_M) + arow * 1024u, (const bf16_t*)(ws + WS_WTOUT) + (size_t)l * 1024 * 1024 + bcol * 1024u, g);
#pragma unroll
        for (int r = 0; r < 4; ++r) { const int sr = 16 * w + 4 * g + r;
            const unsigned o = (unsigned)sr * 1024u + bcol; bf16_t* yb = (bf16_t*)(ws + A_Y0) + (size_t)RP * 1024;
            const float xres = l == 0 ? xin_s[o] : bf2f(yb[o]);
            const float y = xres + mod[(unsigned)(BATCH + (sr >> 2)) * 3072u + bcol] * acc[r];
            if (l == DEPTH - 1) yout_s[o] = y; else yb[o] = (bf16_t)f2bf(y); }
    }
}

struct ProjOrder : pg8::StaticOrder {
    const char* A0; const char* B0;
    __device__ __forceinline__ bool next(int i, pg8::Unit& u) const { if (!pg8::StaticOrder::next(i / 3, u)) return false; u.x = i % 3; return true; }
    __device__ __forceinline__ const char* aptr(const pg8::Gemm&, const pg8::Unit& u, size_t tstep) const { return A0 + (size_t)u.x * (A_YB - A_YA) + (size_t)u.pm * tstep; }
    __device__ __forceinline__ const char* bptr(const pg8::Gemm&, const pg8::Unit& u, size_t tstep) const { return B0 + (size_t)u.x * (WS_WTPB - WS_WTPA) + (size_t)u.pn * tstep; }
};
static_assert(A_YC - A_YB == A_YB - A_YA && WS_WTPC - WS_WTPB == WS_WTPB - WS_WTPA, "equally spaced branch buffers");
struct EpiProjAll {
    static constexpr bool PERM = true, AFTER_DRAIN = false;
    KA a;
    __device__ __forceinline__ void operator()(const f32x4 (&acc)[2][2][4][2], const pg8::Unit& u, int wr, int wc, int fr, int fq) const {
        asm volatile("" : "+v"(fr), "+v"(fq));
        unsigned char* ws = a->ws; const int X = u.x;
        const bf16_t* G = (const bf16_t*)(ws + (X == 0 ? A_GA : (X == 1 ? A_GB : A_GC))); bf16_t* T = (bf16_t*)(ws + A_MT); bf16_t* Mb = (bf16_t*)(ws + A_M);
        const int rbase = u.pm * 256 + wr * 64 + fr, cl = wc * 32 + 8 * fq;
#pragma unroll
        for (int ai = 0; ai < 2; ++ai) {
            int row0 = rbase + ai * 128; asm volatile("" : "+v"(row0));
            const unsigned ob = (unsigned)row0 * 1024u + 256u * u.pn + cl;
            u32x4 gv[4][2], tv[4][2];
#pragma unroll
            for (int m = 0; m < 4; ++m)
#pragma unroll
                for (int bj = 0; bj < 2; ++bj) { const unsigned o = ob + (unsigned)m * 16384u + 128u * bj; gv[m][bj] = *(const u32x4*)(G + o); if (X > 0) tv[m][bj] = *(const u32x4*)(T + o); }
#pragma unroll
            for (int m = 0; m < 4; ++m)
#pragma unroll
                for (int bj = 0; bj < 2; ++bj) { const unsigned o = ob + (unsigned)m * 16384u + 128u * bj;
                    f32x4 g0, g1; unpack8(gv[m][bj], g0, g1);
                    f32x4 v0 = g0 * acc[ai][bj][m][0], v1 = g1 * acc[ai][bj][m][1];
                    if (X > 0) { f32x4 t0, t1; unpack8(tv[m][bj], t0, t1); v0 += t0; v1 += t1; }
                    if (X < 2) *(u32x4*)(T + o) = EpiIn::pack8(v0, v1);
                    else *(u32x4*)(Mb + o) = EpiIn::pack8(v0, v1); }
            asm volatile("" ::: "memory"); __builtin_amdgcn_sched_barrier(0); }
    }
};
__device__ __forceinline__ void phase_proj(KA a, const Ctx& c, int l) {
    ProjOrder S; S.init(RP, 1024, c.nblk, c.bid);
    S.A0 = (const char*)(a->ws + A_YA); S.B0 = (const char*)(a->ws + WS_WTPA) + (size_t)l * 1024 * 512 * 2;
    pg8::Gemm g{(const bf16_t*)S.A0, (const bf16_t*)S.B0, RP, 1024, 512}; EpiProjAll E{a};
    pg8::gemm_phase<EpiProjAll, ProjOrder, true, true>(c.lds_las, g, S, E, c.tid);
}

struct EpiOut {
    static constexpr bool PERM = true, AFTER_DRAIN = false;
    KA a; int l; const float* xin_p; const float* xin_s; float* yout_p; float* yout_s;
    __device__ __forceinline__ void operator()(const f32x4 (&acc)[2][2][4][2], const pg8::Unit& u, int wr, int wc, int fr, int fq) const {
        asm volatile("" : "+v"(fr), "+v"(fq));
        const float* mod = (const float*)(a->ws + WS_MOD) + (size_t)l * 40 * 3072 + 2048;
        const int rbase = u.pm * 256 + wr * 64 + fr, cl = wc * 32 + 8 * fq;
        const float* gr = mod + (unsigned)((u.pm * 256) / SEQ) * 3072u + 256u * u.pn + cl;
        f32x4 gg[2][2];
#pragma unroll
        for (int bj = 0; bj < 2; ++bj) { gg[bj][0] = *(const f32x4*)(gr + 128 * bj); gg[bj][1] = *(const f32x4*)(gr + 128 * bj + 4); }
#pragma unroll
        for (int ai = 0; ai < 2; ++ai) {
            int row0 = rbase + ai * 128; asm volatile("" : "+v"(row0));
            const unsigned ob = (unsigned)row0 * 1024u + 256u * u.pn + cl;
            bf16_t* yb = (bf16_t*)(a->ws + A_Y0);
            f32x4 xv[4][2][2];
            if (l == 0) {
#pragma unroll
                for (int m = 0; m < 4; ++m)
#pragma unroll
                    for (int bj = 0; bj < 2; ++bj) { const float* xr = xin_p + ob + (unsigned)m * 16384u + 128u * bj; xv[m][bj][0] = *(const f32x4*)xr; xv[m][bj][1] = *(const f32x4*)(xr + 4); }
            } else {
                u32x4 xw[4][2];
#pragma unroll
                for (int m = 0; m < 4; ++m)
#pragma unroll
                    for (int bj = 0; bj < 2; ++bj) xw[m][bj] = *(const u32x4*)(yb + ob + (unsigned)m * 16384u + 128u * bj);
#pragma unroll
                for (int m = 0; m < 4; ++m)
#pragma unroll
                    for (int bj = 0; bj < 2; ++bj) unpack8(xw[m][bj], xv[m][bj][0], xv[m][bj][1]);
            }
#pragma unroll
            for (int m = 0; m < 4; ++m)
#pragma unroll
                for (int bj = 0; bj < 2; ++bj) { const unsigned o = ob + (unsigned)m * 16384u + 128u * bj;
                    const f32x4 y0 = xv[m][bj][0] + gg[bj][0] * acc[ai][bj][m][0], y1 = xv[m][bj][1] + gg[bj][1] * acc[ai][bj][m][1];
                    if (l == DEPTH - 1) { *(f32x4*)(yout_p + o) = y0; *(f32x4*)(yout_p + o + 4) = y1; }
                    else *(u32x4*)(yb + o) = EpiIn::pack8(y0, y1); }
            asm volatile("" ::: "memory"); __builtin_amdgcn_sched_barrier(0); }
    }
};
__device__ __forceinline__ void phase_out(KA a, const Ctx& c, int l, const float* xin_p, const float* xin_s, float* yout_p, float* yout_s) {
    sample_out(a, c, l, xin_s, yout_s);
    pg8::Gemm g{(const bf16_t*)(a->ws + A_M), (const bf16_t*)(a->ws + WS_WTOUT) + (size_t)l * 1024 * 1024, RP, 1024, 1024};
    pg8::StaticOrder S; S.init(RP, 1024, c.nblk, c.bid);
    EpiOut E{a, l, xin_p, xin_s, yout_p, yout_s};
    pg8::gemm_phase<EpiOut, pg8::StaticOrder, true, true>(c.lds_las, g, S, E, c.tid);
}

constexpr int N_PHASES = 1 + 6 * DEPTH;
__global__ void __launch_bounds__(NT, 2) fwd_kernel(Args a) {
    extern __shared__ __attribute__((aligned(16))) unsigned char lds[];
    Ctx c; c.tid = threadIdx.x; c.lane = c.tid & 63; c.wave = __builtin_amdgcn_readfirstlane(c.tid >> 6); c.bid = blockIdx.x; c.nblk = gridDim.x; c.lds = lds; c.lds_las = (LAS unsigned char*)lds;
    volatile LAS unsigned* misc = (volatile LAS unsigned*)((LAS unsigned char*)lds + (LDS_BYTES - 64));
    if (c.tid < 16) misc[c.tid] = 0u;
    __syncthreads();
    XcdBarrier bar; bar.bar = (unsigned*)(a.ws + WS_CTL) + 4096; bar.x = 0; bar.st = misc;
    if (a.use_bar) bar = xcd_barrier_post((unsigned*)(a.ws + WS_CTL) + 4096, misc, c.tid);
    const int lo = a.ph_lo, hi = a.ph_hi;
#define IN(k) (lo <= (k) && (k) < hi)
#define SEAM(k) do { if (IN(k) && IN((k) + 1)) xcd_barrier(bar, c.tid); } while (0)
#define PHASE(...) do { KA ka = (KA)__builtin_amdgcn_kernarg_segment_ptr(); asm volatile("" : "+s"(ka)); \
        c.lane = (int)__builtin_amdgcn_mbcnt_hi(~0u, __builtin_amdgcn_mbcnt_lo(~0u, 0u)); c.tid = c.wave * 64 + c.lane;     \
        asm volatile("" : "+v"(c.tid), "+v"(c.lane), "+s"(c.wave), "+s"(c.bid), "+s"(c.nblk)); __VA_ARGS__; } while (0)
    if (IN(0)) { PHASE(phase_pre(ka, c)); SEAM(0); }
#pragma unroll 1
    for (int l_ = 0; l_ < DEPTH; ++l_) {
        int l = l_; asm volatile("" : "+s"(l));
        const int p0 = 1 + 6 * l;
#define XIO const float* xin_p = l == 0 ? ka->x_prompt : (const float*)(ka->ws + A_Y0); const float* xin_s = l == 0 ? ka->x_sample : (const float*)(ka->ws + A_Y0) + (size_t)RP * 1024; \
        float* yout_p = l == DEPTH - 1 ? ka->out + O_YP : (float*)(ka->ws + A_Y0); float* yout_s = l == DEPTH - 1 ? ka->out + O_YS : (float*)(ka->ws + A_Y0) + (size_t)RP * 1024
        if (IN(p0 + 0)) { PHASE(XIO; (void)yout_p; (void)yout_s; phase_norm(ka, c, l, xin_p, xin_s)); SEAM(p0 + 0); }
        if (IN(p0 + 1)) { PHASE(phase_inproj(ka, c, l)); PHASE(hgrn_early(ka, c, l)); SEAM(p0 + 1); }
        if (IN(p0 + 2)) { PHASE(mix_all(ka, c, l)); SEAM(p0 + 2); }
        if (IN(p0 + 3)) { PHASE(phase_attn(ka, c, l)); SEAM(p0 + 3); }
        if (IN(p0 + 4)) { PHASE(phase_proj(ka, c, l)); SEAM(p0 + 4); }
        if (IN(p0 + 5)) { PHASE(XIO; phase_out(ka, c, l, xin_p, xin_s, yout_p, yout_s)); SEAM(p0 + 5); }
    }
#undef IN
#undef SEAM
#undef PHASE
#undef XIO
}

#ifndef N_LAUNCH_MODE
#define N_LAUNCH_MODE 1
#endif
extern "C" void kernel_launch(void* const* d_in, const int* in_sizes, int n_in, void* d_out, int out_size, void* d_ws, size_t ws_size, hipStream_t stream) {
    static int grid = 0;
    if (grid == 0) {
        if (n_in != 26 || (size_t)out_size != O_END || ws_size < WS_NEED) { fprintf(stderr, "kernel_launch: shape mismatch n_in %d out %d ws %zu (need %zu)\n", n_in, out_size, ws_size, (size_t)WS_NEED); grid = -1; return; }
        int dev = 0, cus = 0;
        if (hipGetDevice(&dev) != hipSuccess || hipDeviceGetAttribute(&cus, hipDeviceAttributeMultiprocessorCount, dev) != hipSuccess) { grid = -1; return; }
        if (hipFuncSetAttribute((const void*)fwd_kernel, hipFuncAttributeMaxDynamicSharedMemorySize, LDS_BYTES) != hipSuccess) { grid = -1; return; }
        int per_cu = 0;
        (void)hipOccupancyMaxActiveBlocksPerMultiprocessor(&per_cu, (const void*)fwd_kernel, NT, LDS_BYTES);
        (void)hipGetLastError();
        grid = cus;
    }
    if (grid < 0) return;
    (void)hipMemsetAsync((char*)d_ws + WS_CTL, 0, CTL_ZERO_BYTES, stream);
    Args a{};
    a.x_prompt = (const float*)d_in[0]; a.x_sample = (const float*)d_in[1]; a.cache_k = (const float*)d_in[2]; a.cache_v = (const float*)d_in[3]; a.cache_idx_k = (const float*)d_in[4];
    a.state_conv = (const float*)d_in[5]; a.state_hgrn = (const float*)d_in[6]; a.page_table = (const int*)d_in[7]; a.c_prompt = (const float*)d_in[8]; a.c_sample = (const float*)d_in[9];
    a.w_ada = (const float*)d_in[10]; a.b_ada = (const float*)d_in[11]; a.norm_g = (const float*)d_in[12]; a.w_in = (const float*)d_in[13]; a.w_dw = (const float*)d_in[14];
    a.b_dw = (const float*)d_in[15]; a.ln_g = (const float*)d_in[16]; a.ln_b = (const float*)d_in[17]; a.q_norm_g = (const float*)d_in[18]; a.k_norm_g = (const float*)d_in[19];
    a.lb_logits = (const float*)d_in[20]; a.c_norm_g = (const float*)d_in[21]; a.w_proj_a = (const float*)d_in[22]; a.w_proj_b = (const float*)d_in[23]; a.w_proj_c = (const float*)d_in[24];
    a.w_out = (const float*)d_in[25]; a.out = (float*)d_out; a.ws = (unsigned char*)d_ws;
#if N_LAUNCH_MODE == 1
    a.ph_lo = 0; a.ph_hi = N_PHASES; a.use_bar = 1;
    hipLaunchKernelGGL(fwd_kernel, dim3(grid), dim3(NT), LDS_BYTES, stream, a);
#else
    for (int ph = 0; ph < N_PHASES; ++ph) { a.ph_lo = ph; a.ph_hi = ph + 1; a.use_bar = 0; hipLaunchKernelGGL(fwd_kernel, dim3(grid), dim3(NT), LDS_BYTES, stream, a); }
#endif
}
```

```cpp
#include <hip/hip_runtime.h>
#include <cstdio>
#include <cstdint>
#include <cmath>

constexpr int D_MODEL = 1024, BATCH = 8, SEQ = 2048, DEPTH = 2, DEC_BATCH = 32, DEC_SEQ = 4, PAST_LEN = 8192, PAGE = 128;
constexpr int D_A = 512, CONV_W = 31, N_HEADS = 8, N_KV = 2, HD = 64, D_B = 512, KV_DIM = 128, IDX_HEADS = 4, IDX_DIM = 64, TOPK = 256;
constexpr int C_HEADS = 4, C_KDIM = 128, C_VDIM = 128, D_C = 512, C_FDIM = 512;
constexpr int N_IN = 8260;
constexpr int N_PAGES = PAST_LEN / PAGE;
constexpr int N_POOL = (DEC_BATCH * N_PAGES * 5) / 4;
constexpr int RP = BATCH * SEQ;
constexpr int RS = DEC_BATCH * DEC_SEQ;
constexpr int R = RP + RS;
constexpr float EPS = 1e-6f;
constexpr int Z_AVAL = 0, Z_AGLU = 512, Z_AGATE = 1024, Z_Q = 1536, Z_K = 2048, Z_V = 2176, Z_QI = 2304, Z_KI = 2560, Z_WI = 2624, Z_BGATE = 2628,
              Z_CQ = 3140, Z_CF = 3652, Z_CI = 4164, Z_CGATE = 4676, Z_GA = 5188, Z_GB = 6212, Z_GC = 7236;
static_assert(Z_GC + 1024 == N_IN, "splits");
constexpr size_t O_YP = 0, O_YS = O_YP + (size_t)RP * D_MODEL, O_KP = O_YS + (size_t)RS * D_MODEL, O_VP = O_KP + (size_t)DEPTH * RP * KV_DIM,
                 O_IKP = O_VP + (size_t)DEPTH * RP * KV_DIM, O_CVP = O_IKP + (size_t)DEPTH * RP * IDX_DIM, O_HGP = O_CVP + (size_t)DEPTH * BATCH * 30 * D_A,
                 O_KS = O_HGP + (size_t)DEPTH * BATCH * C_HEADS * C_KDIM * C_VDIM, O_VS = O_KS + (size_t)DEPTH * RS * KV_DIM, O_IKS = O_VS + (size_t)DEPTH * RS * KV_DIM,
                 O_CVS = O_IKS + (size_t)DEPTH * RS * IDX_DIM, O_HGS = O_CVS + (size_t)DEPTH * DEC_BATCH * 30 * D_A,
                 O_END = O_HGS + (size_t)DEPTH * DEC_BATCH * C_HEADS * C_KDIM * C_VDIM;

constexpr size_t MiB = 1u << 20;
constexpr size_t WS_CTL = 0, CTL_ZERO_BYTES = 64 * 1024;
constexpr size_t WS_MOD = 1 * MiB;
constexpr size_t WS_ROPE = 2 * MiB;
constexpr size_t WS_LB = 3 * MiB;
constexpr int RPAD = 16640, NPAD = 8448;
constexpr size_t WS_WTIN = 4 * MiB;
constexpr size_t WS_WTPA = 37 * MiB, WS_WTPB = 39 * MiB, WS_WTPC = 41 * MiB;
constexpr size_t WS_WTOUT = 43 * MiB;
constexpr size_t WS_H = 48 * MiB;
constexpr size_t WS_ACT = 81 * MiB;
constexpr size_t B512 = (size_t)RPAD * 512 * 2;
constexpr size_t A_U = WS_ACT, A_AG = A_U + B512, A_Q = A_AG + B512, A_BG = A_Q + B512, A_CQ = A_BG + B512, A_KK = A_CQ + B512, A_CI = A_KK + B512, A_CG = A_CI + B512,
                 A_LF = A_CG + B512  , A_K = A_LF + 2 * B512, A_V = A_K + B512 / 4, A_QI = A_V + B512 / 4, A_KI = A_QI + B512 / 2, A_WI = A_KI + B512 / 8  ,
                 A_GA = A_WI + (size_t)RPAD * 16, A_GB = A_GA + 2 * B512, A_GC = A_GB + 2 * B512,
                 A_YA = A_GC + 2 * B512, A_YB = A_YA + B512, A_YC = A_YB + B512  , A_MT = A_YC + B512  ,
                 A_M = A_MT + 4 * B512  , A_Y0 = A_M + 2 * B512, A_SELM = A_Y0 + (size_t)R * 1024 * 4  , A_VT = A_SELM + (size_t)RP * 64 * 4  ,
                 A_END = A_VT + (size_t)BATCH * 2 * 64 * SEQ * 2;
constexpr size_t WS_NEED = A_END;
static_assert(WS_WTIN + (size_t)2 * NPAD * 1024 * 2 <= WS_WTPA && WS_H + (size_t)RPAD * 1024 * 2 <= WS_ACT && A_END < 1200 * MiB, "ws map");

constexpr int LDS_BYTES = 147456;
constexpr int NT = 512;
#define LAS __attribute__((address_space(3)))

#define XB_TMO      128
#define XB_XCNT(j)  (256  + 64 * (j))
#define XB_XSUB(j)  (1280 + 64 * (j))
#define XB_XGEN(j)  (2304 + 64 * (j))
#define XB_TOP      3328
#define XB_TOPGEN   3392
#define XCD_BAR_WORDS 3456
#define XB_SPIN_CAP (1u << 22)
__device__ __forceinline__ unsigned xb_ld(unsigned* p)              { return __hip_atomic_load(p, __ATOMIC_RELAXED, __HIP_MEMORY_SCOPE_AGENT); }
__device__ __forceinline__ unsigned xb_add(unsigned* p, unsigned v) { return __hip_atomic_fetch_add(p, v, __ATOMIC_RELAXED, __HIP_MEMORY_SCOPE_AGENT); }
__device__ __forceinline__ unsigned xb_xcc_id() { return (unsigned)__builtin_amdgcn_s_getreg((3 << 11) | 20) & 0xFu; }
#define XB_SPIN(cond, bar) do { unsigned _sp = 0; while (cond) { __builtin_amdgcn_s_sleep(1); \
    if ((++_sp & 255u) == 0u) { if (xb_ld(&(bar)[XB_TMO])) break; if (_sp > XB_SPIN_CAP) { atomicAdd(&(bar)[XB_TMO], 1u); break; } } } } while (0)
struct XcdBarrier { unsigned* bar; unsigned x; volatile LAS unsigned* st; };
__device__ __forceinline__ XcdBarrier xcd_barrier_post(unsigned* bar, volatile LAS unsigned* st, int tid) {
    XcdBarrier b; b.bar = bar; b.x = xb_xcc_id(); b.st = st;
    if (tid == 0) (void)xb_add(&bar[XB_XCNT(b.x)], 1u);
    return b;
}
__device__ __forceinline__ void xcd_barrier_complete(unsigned* bar, unsigned x, unsigned& nloc, unsigned& nx) {
    const unsigned G = gridDim.x * gridDim.y * gridDim.z;
    unsigned sum, cnt, mine, sp = 0u;
    for (;;) {
        sum = 0u; cnt = 0u; mine = 0u;
#pragma unroll
        for (unsigned j = 0; j < 16; ++j) { const unsigned c = xb_ld(&bar[XB_XCNT(j)]); sum += c; cnt += (c > 0u) ? 1u : 0u; mine = (j == x) ? c : mine; }
        if (sum == G) break;
        __builtin_amdgcn_s_sleep(1);
        if ((++sp & 255u) == 0u) { if (xb_ld(&bar[XB_TMO])) break; if (sp > XB_SPIN_CAP) { atomicAdd(&bar[XB_TMO], 1u); break; } }
    }
    nloc = mine > 0u ? mine : 1u; nx = cnt > 0u ? cnt : 1u;
}
__device__ __forceinline__ void xcd_barrier(const XcdBarrier& b, int tid) {
    asm volatile("s_waitcnt vmcnt(0)" ::: "memory");
    __syncthreads();
    if (tid == 0) {
        unsigned* bar = b.bar;
        __builtin_amdgcn_s_waitcnt(0);
        unsigned nloc = b.st[0], nx = b.st[1];
        if (nloc == 0u) { xcd_barrier_complete(bar, b.x, nloc, nx); b.st[0] = nloc; b.st[1] = nx; }
        const unsigned old = xb_add(&bar[XB_XSUB(b.x)], 1u);
        const unsigned gen = old / nloc;
        if (old + 1u == (gen + 1u) * nloc) {
            __builtin_amdgcn_fence(__ATOMIC_RELEASE, "agent");
            asm volatile("s_waitcnt vmcnt(0)" ::: "memory");
            const unsigned og = xb_add(&bar[XB_TOP], 1u);
            const unsigned tg = og / nx;
            if (og + 1u == (tg + 1u) * nx) xb_add(&bar[XB_TOPGEN], 1u);
            else XB_SPIN(xb_ld(&bar[XB_TOPGEN]) == tg, bar);
            __builtin_amdgcn_fence(__ATOMIC_ACQUIRE, "agent");
            xb_add(&bar[XB_XGEN(b.x)], 1u);
            asm volatile("s_waitcnt vmcnt(0)" ::: "memory");
        } else {
            XB_SPIN(xb_ld(&bar[XB_XGEN(b.x)]) == gen, bar);
            __builtin_amdgcn_fence(__ATOMIC_ACQUIRE, "agent");
            asm volatile("s_waitcnt vmcnt(0)" ::: "memory");
        }
    }
    __syncthreads();
}

namespace pg8 {
#define PG8_LAS __attribute__((address_space(3)))
typedef unsigned short bf16_t;
typedef short bf16x8 __attribute__((ext_vector_type(8)));
typedef float f32x4 __attribute__((ext_vector_type(4)));
typedef unsigned u32x4 __attribute__((ext_vector_type(4)));
constexpr int BM = 256, BK = 64, HALF = 128, HTB = HALF * BK * 2  , STAGE_BYTES = 8 * HTB, NXCD = 8, WGM = 8;

__host__ __device__ __forceinline__ int lds_byte(int r, int c) { const int st = (r >> 4) * 2 + (c >> 5), rr = r & 15, cc = c & 31, ob = rr * 64 + cc * 2; return st * 1024 + (ob ^ (((ob >> 9) & 1) << 5)); }
__host__ __device__ __forceinline__ void stage_rc(int b, int& R, int& C) { const int st = b / 1024, sb = b % 1024, swz = sb ^ (((sb >> 9) & 1) << 5); R = (st >> 1) * 16 + swz / 64; C = (st & 1) * 32 + (swz % 64) / 2; }
__host__ __device__ __forceinline__ int perm32(int rho) { const int n = rho >> 4, i = rho & 15; return 8 * (i >> 2) + 4 * n + (i & 3); }

struct Unit { int pm, pn, x; };
struct Gemm { const bf16_t* A; const bf16_t* Bt; int M, N, K; };

struct StaticOrder {
    int nM, nN, nwg, G, c;
    __host__ __device__ void init(int M, int N, int G_, int c_) { nM = M / BM; nN = N / BM; nwg = nM * nN; G = G_; c = c_; }
    __host__ __device__ bool next(int i, Unit& u) const {
        const long L = (long)i * G + c; if (L >= nwg) return false;
        int wgid = (int)L; { const int q = nwg / NXCD, r = nwg % NXCD, xcd = wgid % NXCD, off = wgid / NXCD; wgid = (xcd < r ? xcd * (q + 1) : r * (q + 1) + (xcd - r) * q) + off; }
        const int nig = WGM * nN, gid = wgid / nig, fm = gid * WGM, gsz = (nM - fm) < WGM ? (nM - fm) : WGM;
        u.pm = fm + ((wgid % nig) % gsz); u.pn = (wgid % nig) / gsz; u.x = 0; return true;
    }
    __device__ __forceinline__ const char* aptr(const Gemm& g, const Unit& u, size_t tstep) const { return (const char*)g.A + (size_t)u.pm * tstep; }
    __device__ __forceinline__ const char* bptr(const Gemm& g, const Unit& u, size_t tstep) const { return (const char*)g.Bt + (size_t)u.pn * tstep; }
    __device__ __forceinline__ void a_ready(const Unit&) const {}
    __device__ __forceinline__ void done(const Unit&, int) const {}
};
__device__ __forceinline__ unsigned cvt_pk_bf16(float lo, float hi) { unsigned r; asm volatile("v_cvt_pk_bf16_f32 %0, %1, %2" : "=v"(r) : "v"(lo), "v"(hi)); return r; }
typedef float f32x2 __attribute__((ext_vector_type(2)));
template <class Epi, class Sched, bool ALIGN_EPI = false, bool SP2 = false>
__device__ __forceinline__ void gemm_phase(PG8_LAS unsigned char* lds, const Gemm g, const Sched& S, const Epi& E, int tid_in) {
    int tid_ = tid_in; asm volatile("" : "+v"(tid_));
    const int tid = tid_, wid = __builtin_amdgcn_readfirstlane(tid >> 6), lane = tid & 63, wr = wid >> 2, wc = wid & 3, fr = lane & 15, fq = lane >> 4;
    const int K = g.K, nt = K / BK;
    unsigned voffA[2], voffB[2];
#pragma unroll
    for (int i = 0; i < 2; ++i) { int R, C; stage_rc(tid * 16 + i * 8192, R, C); const int Rb = Epi::PERM ? ((R & ~31) + perm32(R & 31)) : R;
        voffA[i] = (unsigned)(R * K + C) * 2u; voffB[i] = (unsigned)(Rb * K + C) * 2u; }
    const size_t kstep = (size_t)(BK * 2);
    const size_t hstep = (size_t)HALF * K * 2;
    const size_t tstep = 2 * hstep;
    const unsigned ldsw = (unsigned)wid * 1024u;
    const int aoff = lds_byte(wr * 64 + fr, fq * 8), boff = lds_byte(wc * 32 + fr, fq * 8);
#define PG8_SA(b, h) (((b) * 2 + (h)) * HTB)
#define PG8_SB(b, h) ((4 + (b) * 2 + (h)) * HTB)
#define PG8_STAGE(bufoff, gbase, voff) do { _Pragma("unroll") for (int _i = 0; _i < 2; ++_i) \
        __builtin_amdgcn_global_load_lds((const unsigned*)((const char*)(gbase) + (voff)[_i]), (PG8_LAS unsigned*)(lds + (bufoff) + ldsw + _i * 8192), 16, 0, 0); } while (0)
#define PG8_LDA(dst, b, h) do { _Pragma("unroll") for (int m = 0; m < 4; ++m) _Pragma("unroll") for (int k = 0; k < 2; ++k) dst[m][k] = *(const PG8_LAS bf16x8*)(lds + PG8_SA(b, h) + aoff + m * 2048 + k * 1024); } while (0)
#define PG8_LDB(dst, b, h) do { _Pragma("unroll") for (int n = 0; n < 2; ++n) _Pragma("unroll") for (int k = 0; k < 2; ++k) dst[n][k] = *(const PG8_LAS bf16x8*)(lds + PG8_SB(b, h) + boff + n * 2048 + k * 1024); } while (0)
#define PG8_MMA(ai, bj, At, Bt) do { __builtin_amdgcn_s_setprio(1); _Pragma("unroll") for (int m = 0; m < 4; ++m) _Pragma("unroll") for (int n = 0; n < 2; ++n) _Pragma("unroll") for (int k = 0; k < 2; ++k) \
        acc[ai][bj][m][n] = __builtin_amdgcn_mfma_f32_16x16x32_bf16(Bt[n][k], At[m][k], acc[ai][bj][m][n], 0, 0, 0); __builtin_amdgcn_s_setprio(0); } while (0)
#define PG8_WAIT_V(n) asm volatile("s_waitcnt vmcnt(" #n ")" ::: "memory")
#define PG8_WAIT_L(n) asm volatile("s_waitcnt lgkmcnt(" #n ")" ::: "memory")
#define PG8_BAR __builtin_amdgcn_s_barrier()
#define PG8_SCHED __builtin_amdgcn_sched_barrier(0)
    Unit cur, nxt; int ui = 0;
    if (!S.next(0, cur)) return;
    f32x4 acc[2][2][4][2];
#pragma unroll
    for (int a = 0; a < 2; ++a)
#pragma unroll
        for (int b = 0; b < 2; ++b)
#pragma unroll
            for (int m = 0; m < 4; ++m)
#pragma unroll
                for (int n = 0; n < 2; ++n) acc[a][b][m][n] = (f32x4){0.f, 0.f, 0.f, 0.f};
    bf16x8 At[4][2], B0[2][2], B1[2][2];
    const char* cA = S.aptr(g, cur, tstep); const char* cB = S.bptr(g, cur, tstep);
    S.a_ready(cur);
    if constexpr (SP2) {
        PG8_STAGE(PG8_SB(0, 0), cB, voffB); PG8_STAGE(PG8_SB(0, 1), cB + hstep, voffB); PG8_STAGE(PG8_SA(0, 0), cA, voffA); PG8_STAGE(PG8_SA(0, 1), cA + hstep, voffA);
        if (wr == 1) PG8_BAR;
        PG8_WAIT_V(2); PG8_BAR;
        PG8_STAGE(PG8_SB(1, 0), cB + kstep, voffB); PG8_STAGE(PG8_SA(1, 0), cA + kstep, voffA); PG8_STAGE(PG8_SB(1, 1), cB + hstep + kstep, voffB);
        PG8_WAIT_V(6); PG8_BAR;
    } else {
        PG8_STAGE(PG8_SB(0, 0), cB, voffB); PG8_STAGE(PG8_SA(0, 0), cA, voffA); PG8_STAGE(PG8_SB(0, 1), cB + hstep, voffB); PG8_STAGE(PG8_SA(0, 1), cA + hstep, voffA);
        if (wr == 1) PG8_BAR;
        PG8_WAIT_V(4); PG8_BAR;
        PG8_STAGE(PG8_SB(1, 0), cB + kstep, voffB); PG8_STAGE(PG8_SA(1, 0), cA + kstep, voffA); PG8_STAGE(PG8_SB(1, 1), cB + hstep + kstep, voffB);
        PG8_WAIT_V(6); PG8_BAR;
    }
    for (;;) {
        const bool has_next = S.next(ui + 1, nxt);
        const char* nA = has_next ? S.aptr(g, nxt, tstep) : cA; const char* nB = has_next ? S.bptr(g, nxt, tstep) : cB;
        for (int t = 0; t < nt; t += 2) {
            const bool last = (t == nt - 2);
            const char* a1 = cA + (size_t)(t + 1) * kstep;
            const char* a2 = last ? nA : cA + (size_t)(t + 2) * kstep; const char* b2 = last ? nB : cB + (size_t)(t + 2) * kstep;
            const char* a3 = a2 + kstep; const char* b3 = b2 + kstep;
            if (last && has_next) S.a_ready(nxt);
            if constexpr (SP2) {
            PG8_LDB(B0, 0, 0); PG8_LDB(B1, 0, 1); PG8_SCHED; PG8_LDA(At, 0, 0); PG8_STAGE(PG8_SA(1, 1), a1 + hstep, voffA);
            PG8_WAIT_V(8); PG8_WAIT_L(0); PG8_BAR; PG8_MMA(0, 0, At, B0); PG8_MMA(0, 1, At, B1); PG8_BAR; PG8_SCHED;
            PG8_LDA(At, 0, 1); PG8_STAGE(PG8_SB(0, 0), b2, voffB); PG8_STAGE(PG8_SB(0, 1), b2 + hstep, voffB); PG8_STAGE(PG8_SA(0, 0), a2, voffA);
            PG8_WAIT_V(8); PG8_WAIT_L(0); PG8_BAR; PG8_MMA(1, 0, At, B0); PG8_MMA(1, 1, At, B1); PG8_BAR; PG8_SCHED;
            PG8_LDB(B0, 1, 0); PG8_LDB(B1, 1, 1); PG8_SCHED; PG8_LDA(At, 1, 0); PG8_STAGE(PG8_SA(0, 1), a2 + hstep, voffA);
            PG8_WAIT_V(8); PG8_WAIT_L(0); PG8_BAR; PG8_MMA(0, 0, At, B0); PG8_MMA(0, 1, At, B1); PG8_BAR; PG8_SCHED;
            PG8_LDA(At, 1, 1); PG8_STAGE(PG8_SB(1, 0), b3, voffB); PG8_STAGE(PG8_SB(1, 1), b3 + hstep, voffB); PG8_STAGE(PG8_SA(1, 0), a3, voffA);
            PG8_WAIT_V(8); PG8_WAIT_L(0); PG8_BAR; PG8_MMA(1, 0, At, B0); PG8_MMA(1, 1, At, B1); PG8_BAR; PG8_SCHED;
            } else {
            PG8_LDB(B0, 0, 0); PG8_SCHED; PG8_LDA(At, 0, 0); PG8_STAGE(PG8_SA(1, 1), a1 + hstep, voffA);
            PG8_WAIT_L(8); PG8_BAR; PG8_WAIT_L(0); PG8_MMA(0, 0, At, B0); PG8_BAR; PG8_SCHED;
            PG8_LDB(B1, 0, 1); PG8_STAGE(PG8_SB(0, 0), b2, voffB);
            PG8_BAR; PG8_WAIT_L(0); PG8_MMA(0, 1, At, B1); PG8_BAR;
            PG8_LDA(At, 0, 1); PG8_STAGE(PG8_SA(0, 0), a2, voffA);
            PG8_BAR; PG8_WAIT_L(0); PG8_MMA(1, 0, At, B0); PG8_BAR; PG8_SCHED;
            PG8_STAGE(PG8_SB(0, 1), b2 + hstep, voffB);
            PG8_WAIT_V(6); PG8_BAR; PG8_MMA(1, 1, At, B1); PG8_BAR;
            PG8_LDB(B0, 1, 0); PG8_SCHED; PG8_LDA(At, 1, 0); PG8_STAGE(PG8_SA(0, 1), a2 + hstep, voffA);
            PG8_WAIT_L(8); PG8_BAR; PG8_WAIT_L(0); PG8_MMA(0, 0, At, B0); PG8_BAR; PG8_SCHED;
            PG8_LDB(B1, 1, 1); PG8_STAGE(PG8_SB(1, 0), b3, voffB);
            PG8_BAR; PG8_WAIT_L(0); PG8_MMA(0, 1, At, B1); PG8_BAR;
            PG8_LDA(At, 1, 1); PG8_STAGE(PG8_SA(1, 0), a3, voffA);
            PG8_BAR; PG8_WAIT_L(0); PG8_MMA(1, 0, At, B0); PG8_BAR; PG8_SCHED;
            PG8_STAGE(PG8_SB(1, 1), b3 + hstep, voffB);
            PG8_WAIT_V(6); PG8_BAR; PG8_MMA(1, 1, At, B1); PG8_BAR;
            }
        }
        if constexpr (ALIGN_EPI) { if (wr == 0) PG8_BAR; }
        if constexpr (!Epi::AFTER_DRAIN) { E(acc, cur, wr, wc, fr, fq); S.done(cur, ui); }
        if (!has_next) break;
#pragma unroll
        for (int a = 0; a < 2; ++a)
#pragma unroll
            for (int b = 0; b < 2; ++b)
#pragma unroll
                for (int m = 0; m < 4; ++m)
#pragma unroll
                    for (int n = 0; n < 2; ++n) acc[a][b][m][n] = (f32x4){0.f, 0.f, 0.f, 0.f};
        cur = nxt; cA = nA; cB = nB; ++ui;
        if constexpr (ALIGN_EPI) { if (wr == 1) PG8_BAR; }
    }
    PG8_WAIT_V(0);
    if constexpr (!ALIGN_EPI) { if (wr == 0) PG8_BAR; }
    PG8_BAR;
    if constexpr (Epi::AFTER_DRAIN) { E.fused(acc, cur, wr, wc, fr, fq, lds, wid, lane); S.done(cur, ui); }
#undef PG8_SA
#undef PG8_SB
#undef PG8_STAGE
#undef PG8_LDA
#undef PG8_LDB
#undef PG8_MMA
#undef PG8_WAIT_V
#undef PG8_WAIT_L
#undef PG8_BAR
#undef PG8_SCHED
}
}

struct Args {
    const float* x_prompt; const float* x_sample; const float* cache_k; const float* cache_v; const float* cache_idx_k; const float* state_conv; const float* state_hgrn;
    const int* page_table; const float* c_prompt; const float* c_sample; const float* w_ada; const float* b_ada; const float* norm_g; const float* w_in; const float* w_dw;
    const float* b_dw; const float* ln_g; const float* ln_b; const float* q_norm_g; const float* k_norm_g; const float* lb_logits; const float* c_norm_g;
    const float* w_proj_a; const float* w_proj_b; const float* w_proj_c; const float* w_out;
    float* out; unsigned char* ws; int ph_lo, ph_hi, use_bar, pad;
};
typedef const Args __attribute__((address_space(4)))* KA;
struct Ctx {
    int tid, lane, wave, bid, nblk;
    unsigned char* lds;
    LAS unsigned char* lds_las;
};

__device__ __forceinline__ float silu_f(float x) { return x / (1.f + __expf(-x)); }
__device__ __forceinline__ float sigmoid_f(float x) { return 1.f / (1.f + __expf(-x)); }
__device__ __forceinline__ float fsig(float x) { return __builtin_amdgcn_rcpf(1.f + __expf(-x)); }
typedef unsigned short bf16_t;
typedef float f32x4 __attribute__((ext_vector_type(4)));
typedef unsigned u32x4 __attribute__((ext_vector_type(4)));
typedef short bf16x8_t __attribute__((ext_vector_type(8)));
typedef unsigned u32x2 __attribute__((ext_vector_type(2)));
__device__ __forceinline__ float bf2f(bf16_t v) { return __uint_as_float((unsigned)v << 16); }
__device__ __forceinline__ float LD(const bf16_t* p, size_t i) { return bf2f(p[i]); }
__device__ __forceinline__ unsigned f2bf(float f) { unsigned u = __float_as_uint(f); return (u + 0x7fffu + ((u >> 16) & 1u)) >> 16; }
__device__ __forceinline__ unsigned pk2(float lo, float hi) { return f2bf(lo) | (f2bf(hi) << 16); }
__device__ __forceinline__ void ld8(const bf16_t* p, float (&o)[8]) { const u32x4 w = *(const u32x4*)p;
    o[0] = __uint_as_float(w.x << 16); o[1] = __uint_as_float(w.x & 0xffff0000u); o[2] = __uint_as_float(w.y << 16); o[3] = __uint_as_float(w.y & 0xffff0000u);
    o[4] = __uint_as_float(w.z << 16); o[5] = __uint_as_float(w.z & 0xffff0000u); o[6] = __uint_as_float(w.w << 16); o[7] = __uint_as_float(w.w & 0xffff0000u); }
__device__ __forceinline__ void ld8(const float* p, float (&o)[8]) { const float4 a = *(const float4*)p, b = *(const float4*)(p + 4); o[0] = a.x; o[1] = a.y; o[2] = a.z; o[3] = a.w; o[4] = b.x; o[5] = b.y; o[6] = b.z; o[7] = b.w; }
__device__ __forceinline__ void unpack8(const u32x4& w, f32x4& lo, f32x4& hi) {
    lo = (f32x4){__uint_as_float(w.x << 16), __uint_as_float(w.x & 0xffff0000u), __uint_as_float(w.y << 16), __uint_as_float(w.y & 0xffff0000u)};
    hi = (f32x4){__uint_as_float(w.z << 16), __uint_as_float(w.z & 0xffff0000u), __uint_as_float(w.w << 16), __uint_as_float(w.w & 0xffff0000u)}; }
__device__ __forceinline__ float wave_sum(float v) {
#pragma unroll
    for (int o = 1; o < 64; o <<= 1) v += __shfl_xor(v, o);
    return v;
}
__device__ __forceinline__ float wave_max(float v) {
#pragma unroll
    for (int o = 1; o < 64; o <<= 1) v = fmaxf(v, __shfl_xor(v, o));
    return v;
}
__device__ __forceinline__ float block_sum(const Ctx& c, float v, float* red) {
    v = wave_sum(v);
    __syncthreads();
    if (c.lane == 0) red[c.wave] = v;
    __syncthreads();
    float s = 0.f;
#pragma unroll
    for (int w = 0; w < NT / 64; ++w) s += red[w];
    return s;
}

__device__ __forceinline__ int rope_slot(int row) { return row < RP ? (row % SEQ) : (SEQ + ((row - RP) % DEC_SEQ)); }
__device__ __forceinline__ int mod_row(int row) { return row < RP ? (row / SEQ) : (BATCH + (row - RP) / DEC_SEQ); }

__device__ __forceinline__ int inproj_src(int n) {
    const int pn = n >> 8, c = n & 255, bj = c >> 7, wcol = (c >> 5) & 3, i = c & 31, x = c & 127;
    if (pn < 4) return (bj ? Z_AGLU : Z_AVAL) + 128 * pn + x;
    if (pn < 6) return Z_AGATE + 256 * (pn - 4) + c;
    if (pn < 8) return Z_Q + (4 * (pn - 6) + wcol) * 64 + 32 * bj + i;
    if (pn == 8) return (wcol < 2 ? Z_K + wcol * 64 : Z_V + (wcol - 2) * 64) + 32 * bj + i;
    if (pn == 9) return Z_QI + wcol * 64 + 32 * bj + i;
    if (pn == 10) { if (wcol == 0) return Z_KI + 32 * bj + i; if (wcol == 1 && bj == 0 && i < 4) return Z_WI + i; return -1; }
    if (pn < 13) return Z_BGATE + 256 * (pn - 11) + c;
    if (pn < 15) return Z_CQ + 256 * (pn - 13) + c;
    if (pn < 17) return Z_CF + 256 * (pn - 15) + c;
    if (pn < 19) return Z_CI + 256 * (pn - 17) + c;
    if (pn < 21) return Z_CGATE + 256 * (pn - 19) + c;
    if (pn < 25) return Z_GA + 256 * (pn - 21) + c;
    if (pn < 29) return Z_GB + 256 * (pn - 25) + c;
    return Z_GC + 256 * (pn - 29) + c;
}
constexpr int CW_PREQ = 12288;
template <bool PERMUTE>
__device__ __forceinline__ void transpose_item(const float* W, int K, int N, bf16_t* WT, int nrows, LAS bf16_t* T, int item, int lane) {
    const int nblk = nrows / 64, kb = item / nblk, nb = item % nblk, k0 = 64 * kb, n0 = 64 * nb;
    const int q = lane & 15, r = lane >> 4;
    const int sc = PERMUTE ? inproj_src(n0 + 4 * q) : n0 + 4 * q; const int scc = sc >= 0 ? sc : 0;
    f32x4 v[16];
#pragma unroll
    for (int i = 0; i < 16; ++i) { const int kk = 16 * (i >> 2) + 4 * r + (i & 3); v[i] = *(const f32x4*)(W + (size_t)(k0 + kk) * N + scc); }
    const float zm = sc >= 0 ? 1.f : 0.f;
#pragma unroll
    for (int j = 0; j < 4; ++j)
#pragma unroll
        for (int e = 0; e < 4; ++e) *(LAS u32x2*)(T + (4 * q + e) * 72 + 16 * j + 4 * r) = (u32x2){pk2(v[4 * j][e] * zm, v[4 * j + 1][e] * zm), pk2(v[4 * j + 2][e] * zm, v[4 * j + 3][e] * zm)};
    asm volatile("s_waitcnt lgkmcnt(0)" ::: "memory"); __builtin_amdgcn_wave_barrier();
    const int c = lane & 7;
#pragma unroll
    for (int jj = 0; jj < 8; ++jj) { const int n = (lane >> 3) + 8 * jj; const u32x4 o = *(const LAS u32x4*)(T + n * 72 + 8 * c); *(u32x4*)(WT + (size_t)(n0 + n) * K + k0 + 8 * c) = o; }
    asm volatile("s_waitcnt lgkmcnt(0)" ::: "memory"); __builtin_amdgcn_wave_barrier();
}
__device__ __forceinline__ void phase_pre(KA a, const Ctx& c) {
    float* mod = (float*)(a->ws + WS_MOD); float* rope = (float*)(a->ws + WS_ROPE); float* lbw = (float*)(a->ws + WS_LB);
    const int gtid = c.bid * NT + c.tid, gn = c.nblk * NT;
    {
        LAS float* RED = (LAS float*)c.lds_las;
        const int c16 = c.lane & 15, g = c.lane >> 4;
        for (int it = c.nblk - 1 - c.bid; it < DEPTH * 96; it += c.nblk) {
            const int l = it / 96, j0 = (it % 96) * 32;
            __syncthreads();
            for (int i = c.tid; i < 40 * 32; i += NT) RED[i] = 0.f;
            f32x4 acc[2][3];
#pragma unroll
            for (int jt = 0; jt < 2; ++jt)
#pragma unroll
                for (int rt = 0; rt < 3; ++rt) acc[jt][rt] = (f32x4){0.f, 0.f, 0.f, 0.f};
#pragma unroll 2
            for (int ks = 0; ks < 4; ++ks) {
                const int k0 = 128 * c.wave + 32 * ks + 8 * g;
                float wr[2][8]; f32x4 cr[3][2];
#pragma unroll
                for (int jt = 0; jt < 2; ++jt)
#pragma unroll
                    for (int jj = 0; jj < 8; ++jj) wr[jt][jj] = a->w_ada[((size_t)l * D_MODEL + k0 + jj) * 3072 + j0 + 16 * jt + c16];
#pragma unroll
                for (int rt = 0; rt < 3; ++rt) { const int r = 16 * rt + c16, rc = r < 40 ? r : 39;
                    const float* cp = (rc < BATCH ? a->c_prompt + (size_t)rc * D_MODEL : a->c_sample + (size_t)(rc - BATCH) * D_MODEL) + k0;
                    cr[rt][0] = *(const f32x4*)cp; cr[rt][1] = *(const f32x4*)(cp + 4); }
                bf16x8_t Ah[2], Al[2], Bh[3], Bl[3];
#pragma unroll
                for (int jt = 0; jt < 2; ++jt) { unsigned h[8], lo[8];
#pragma unroll
                    for (int jj = 0; jj < 8; ++jj) { h[jj] = f2bf(wr[jt][jj]); lo[jj] = f2bf(wr[jt][jj] - __uint_as_float(h[jj] << 16)); }
                    Ah[jt] = __builtin_bit_cast(bf16x8_t, (u32x4){h[0] | (h[1] << 16), h[2] | (h[3] << 16), h[4] | (h[5] << 16), h[6] | (h[7] << 16)});
                    Al[jt] = __builtin_bit_cast(bf16x8_t, (u32x4){lo[0] | (lo[1] << 16), lo[2] | (lo[3] << 16), lo[4] | (lo[5] << 16), lo[6] | (lo[7] << 16)}); }
#pragma unroll
                for (int rt = 0; rt < 3; ++rt) { unsigned h[8], lo[8]; const bool live = 16 * rt + c16 < 40;
#pragma unroll
                    for (int jj = 0; jj < 8; ++jj) { const float sv = live ? silu_f(cr[rt][jj >> 2][jj & 3]) : 0.f; h[jj] = f2bf(sv); lo[jj] = f2bf(sv - __uint_as_float(h[jj] << 16)); }
                    Bh[rt] = __builtin_bit_cast(bf16x8_t, (u32x4){h[0] | (h[1] << 16), h[2] | (h[3] << 16), h[4] | (h[5] << 16), h[6] | (h[7] << 16)});
                    Bl[rt] = __builtin_bit_cast(bf16x8_t, (u32x4){lo[0] | (lo[1] << 16), lo[2] | (lo[3] << 16), lo[4] | (lo[5] << 16), lo[6] | (lo[7] << 16)}); }
#pragma unroll
                for (int jt = 0; jt < 2; ++jt)
#pragma unroll
                    for (int rt = 0; rt < 3; ++rt) {
                        acc[jt][rt] = __builtin_amdgcn_mfma_f32_16x16x32_bf16(Al[jt], Bh[rt], acc[jt][rt], 0, 0, 0);
                        acc[jt][rt] = __builtin_amdgcn_mfma_f32_16x16x32_bf16(Ah[jt], Bl[rt], acc[jt][rt], 0, 0, 0);
                        acc[jt][rt] = __builtin_amdgcn_mfma_f32_16x16x32_bf16(Ah[jt], Bh[rt], acc[jt][rt], 0, 0, 0); }
            }
            __syncthreads();
#pragma unroll
            for (int jt = 0; jt < 2; ++jt)
#pragma unroll
                for (int rt = 0; rt < 3; ++rt) { const int r = 16 * rt + c16;
                    if (r < 40) {
#pragma unroll
                        for (int i = 0; i < 4; ++i) atomicAdd((float*)(RED + r * 32 + 16 * jt + 4 * g + i), acc[jt][rt][i]); } }
            __syncthreads();
            for (int i = c.tid; i < 40 * 32; i += NT) { const int r = i >> 5, jj = i & 31; mod[((size_t)l * 40 + r) * 3072 + j0 + jj] = RED[i] + a->b_ada[l * 3072 + j0 + jj]; }
        }
    }
    if (c.bid < 64) for (int i = gtid; i < 2052 * 32; i += 64 * NT) {
        const int j = i % 32, s = i / 32; const double pos = s < SEQ ? (double)s : (double)(PAST_LEN + s - SEQ);
        const double inv = pow(10000.0, -(double)j / 32.0);
        const double ang = pos * inv;
        rope[2 * i] = (float)cos(ang); rope[2 * i + 1] = (float)sin(ang);
    }
    for (int i = gtid; i < C_FDIM; i += gn) {
        const float l0 = a->lb_logits[i], l1 = a->lb_logits[C_FDIM + i]; const float mx = fmaxf(l0, l1);
        const float e0 = expf(l0 - mx), e1 = expf(l1 - mx);
        lbw[i] = 0.f; lbw[C_FDIM + i] = e1 / (e0 + e1);
    }
    __syncthreads();
    {
        LAS bf16_t* TB = (LAS bf16_t*)c.lds_las;
        LAS int* slot = (LAS int*)(c.lds_las + 2 * 36864);
        unsigned* ctr = (unsigned*)(a->ws + WS_CTL) + CW_PREQ;
        constexpr int I_IN = (1024 / 64) * (NPAD / 256), I_P = (512 / 64) * (1024 / 256), I_O = (1024 / 64) * (1024 / 256), PER_L = I_IN + 3 * I_P + I_O;
        constexpr int NITEMS = DEPTH * PER_L;
        const float* W; bf16_t* WT; int N, K, k0, n0, sc; bool perm;
#define PRE_DECODE(it_) do { int r_ = (it_); const int l_ = r_ / PER_L; r_ -= l_ * PER_L; int nblk_; \
            if (r_ < I_IN) { W = a->w_in + (size_t)l_ * 1024 * N_IN; N = N_IN; K = 1024; WT = (bf16_t*)(a->ws + WS_WTIN) + (size_t)l_ * NPAD * 1024; nblk_ = NPAD / 256; perm = true; } \
            else { r_ -= I_IN; nblk_ = 4; perm = false; N = 1024; \
                if (r_ < I_P) { W = a->w_proj_a + (size_t)l_ * 512 * 1024; K = 512; WT = (bf16_t*)(a->ws + WS_WTPA) + (size_t)l_ * 1024 * 512; } \
                else if (r_ < 2 * I_P) { r_ -= I_P; W = a->w_proj_b + (size_t)l_ * 512 * 1024; K = 512; WT = (bf16_t*)(a->ws + WS_WTPB) + (size_t)l_ * 1024 * 512; } \
                else if (r_ < 3 * I_P) { r_ -= 2 * I_P; W = a->w_proj_c + (size_t)l_ * 512 * 1024; K = 512; WT = (bf16_t*)(a->ws + WS_WTPC) + (size_t)l_ * 1024 * 512; } \
                else { r_ -= 3 * I_P; W = a->w_out + (size_t)l_ * 1024 * 1024; K = 1024; WT = (bf16_t*)(a->ws + WS_WTOUT) + (size_t)l_ * 1024 * 1024; } } \
            k0 = 64 * (r_ / nblk_); n0 = 256 * (r_ % nblk_); sc = perm ? inproj_src(n0 + 4 * c.lane) : n0 + 4 * c.lane; } while (0)
#define PRE_LOAD() do { const int scc_ = sc >= 0 ? sc : 0; _Pragma("unroll") for (int i = 0; i < 8; ++i) v[i] = *(const f32x4*)(W + (size_t)(k0 + 8 * c.wave + i) * N + scc_); zm = sc >= 0 ? 1.f : 0.f; } while (0)
        if (c.tid == 0) slot[0] = (int)__hip_atomic_fetch_add(ctr, 1u, __ATOMIC_RELAXED, __HIP_MEMORY_SCOPE_AGENT);
        __syncthreads();
        int it = slot[0], p = 0; f32x4 v[8]; float zm = 0.f;
        if (it < NITEMS) { PRE_DECODE(it); PRE_LOAD(); }
#pragma unroll 1
        while (it < NITEMS) {
            LAS bf16_t* T = TB + p * (256 * 72);
#pragma unroll
            for (int e = 0; e < 4; ++e) *(LAS u32x4*)(T + (4 * c.lane + e) * 72 + 8 * (c.wave ^ (c.lane & 7))) =
                (u32x4){pk2(v[0][e] * zm, v[1][e] * zm), pk2(v[2][e] * zm, v[3][e] * zm), pk2(v[4][e] * zm, v[5][e] * zm), pk2(v[6][e] * zm, v[7][e] * zm)};
            if (c.tid == 0) slot[p ^ 1] = (int)__hip_atomic_fetch_add(ctr, 1u, __ATOMIC_RELAXED, __HIP_MEMORY_SCOPE_AGENT);
            asm volatile("s_waitcnt lgkmcnt(0)" ::: "memory"); __syncthreads();
            const int nxt = slot[p ^ 1];
            bf16_t* dst = WT + (size_t)(n0 + 32 * c.wave + (c.lane >> 3)) * K + k0 + 8 * (c.lane & 7); const int dK = K;
            if (nxt < NITEMS) { PRE_DECODE(nxt); PRE_LOAD(); }
#pragma unroll
            for (int jj = 0; jj < 4; ++jj) { const int n_ = 32 * c.wave + (c.lane >> 3) + 8 * jj; const u32x4 o = *(const LAS u32x4*)(T + n_ * 72 + 8 * ((c.lane & 7) ^ ((n_ >> 2) & 7))); *(u32x4*)(dst + (size_t)(8 * jj) * dK) = o; }
            p ^= 1; it = nxt;
        }
#undef PRE_DECODE
#undef PRE_LOAD
    }
}

__device__ __forceinline__ void phase_norm(KA a, const Ctx& c, int l, const float* xin_p, const float* xin_s) {
    const float* mod = (const float*)(a->ws + WS_MOD) + (size_t)l * 40 * 3072; bf16_t* H = (bf16_t*)(a->ws + WS_H);
    const float* g = a->norm_g + l * D_MODEL;
    const int gw = c.bid * (NT / 64) + c.wave, ngw = c.nblk * (NT / 64);
    const bool xmap = c.nblk == 256;
    const int nit = xmap ? 9 : (RPAD - gw + ngw - 1) / ngw;
    int cur_mr = -1; float4 gs[4], shv[4];
#pragma unroll
    for (int j = 0; j < 4; ++j) { gs[j] = make_float4(0.f, 0.f, 0.f, 0.f); shv[j] = gs[j]; }
    for (int it_ = 0; it_ < nit; ++it_) {
        int row;
        if (xmap) { if (it_ < 8) row = (c.bid & 7) * SEQ + ((c.bid >> 3) * 8 + c.wave) + 256 * it_; else { if (gw >= RPAD - RP) break; row = RP + gw; } }
        else row = gw + it_ * ngw;
        unsigned long long* o8 = (unsigned long long*)(H + (size_t)row * D_MODEL) + c.lane;
        if (row >= R) {
#pragma unroll
            for (int j = 0; j < 4; ++j) o8[64 * j] = 0ull;
            continue;
        }
        const float* xr = row < RP ? xin_p + (size_t)row * D_MODEL : xin_s + (size_t)(row - RP) * D_MODEL;
        const float* mr = mod + (size_t)mod_row(row) * 3072;
        float4 v[4]; float ss = 0.f;
        if (l == 0) {
#pragma unroll
            for (int j = 0; j < 4; ++j) v[j] = *(const float4*)(xr + 4 * c.lane + 256 * j);
        } else {
            const bf16_t* xb = (const bf16_t*)(a->ws + A_Y0) + (size_t)row * D_MODEL;
#pragma unroll
            for (int j = 0; j < 4; ++j) { const u32x2 w2 = *(const u32x2*)(xb + 4 * c.lane + 256 * j);
                v[j] = make_float4(__uint_as_float(w2.x << 16), __uint_as_float(w2.x & 0xffff0000u), __uint_as_float(w2.y << 16), __uint_as_float(w2.y & 0xffff0000u)); }
        }
#pragma unroll
        for (int j = 0; j < 4; ++j) ss += v[j].x * v[j].x + v[j].y * v[j].y + v[j].z * v[j].z + v[j].w * v[j].w;
        ss = wave_sum(ss);
        const float rstd = rsqrtf(ss * (1.f / D_MODEL) + EPS);
        { const int mrow = mod_row(row);
          if (mrow != cur_mr) { cur_mr = mrow;
#pragma unroll
            for (int j = 0; j < 4; ++j) { const int col = 4 * c.lane + 256 * j;
                const float4 gg = *(const float4*)(g + col), sc = *(const float4*)(mr + 1024 + col); shv[j] = *(const float4*)(mr + col);
                gs[j] = make_float4(gg.x * (1.f + sc.x), gg.y * (1.f + sc.y), gg.z * (1.f + sc.z), gg.w * (1.f + sc.w)); } } }
#pragma unroll
        for (int j = 0; j < 4; ++j) {
            const float h0 = v[j].x * rstd * gs[j].x + shv[j].x, h1 = v[j].y * rstd * gs[j].y + shv[j].y,
                        h2 = v[j].z * rstd * gs[j].z + shv[j].z, h3 = v[j].w * rstd * gs[j].w + shv[j].w;
            o8[64 * j] = (unsigned long long)pk2(h0, h1) | ((unsigned long long)pk2(h2, h3) << 32); }
    }
}

struct EpiIn {
    static constexpr bool PERM = true, AFTER_DRAIN = false;
    KA a; int l;
    __device__ __forceinline__ static u32x4 pack8(const f32x4& v0, const f32x4& v1) { u32x4 w; w.x = pg8::cvt_pk_bf16(v0[0], v0[1]); w.y = pg8::cvt_pk_bf16(v0[2], v0[3]); w.z = pg8::cvt_pk_bf16(v1[0], v1[1]); w.w = pg8::cvt_pk_bf16(v1[2], v1[3]); return w; }
    __device__ __forceinline__ void operator()(const f32x4 (&acc)[2][2][4][2], const pg8::Unit& u, int wr, int wc, int fr, int fq) const {
        asm volatile("" : "+v"(fr), "+v"(fq));
        unsigned char* ws = a->ws; float* out = a->out;
        const int pn = u.pn, rbase = u.pm * 256 + wr * 64 + fr, cl = wc * 32 + 8 * fq;
        if (pn < 4) {
            bf16_t* U = (bf16_t*)(ws + A_U);
#pragma unroll
            for (int ai = 0; ai < 2; ++ai)
#pragma unroll
                for (int m = 0; m < 4; ++m) { int row = rbase + ai * 128 + m * 16; asm volatile("" : "+v"(row));     f32x4 uu[2];
#pragma unroll
                    for (int n = 0; n < 2; ++n)
#pragma unroll
                        for (int j = 0; j < 4; ++j) uu[n][j] = acc[ai][0][m][n][j] * fsig(acc[ai][1][m][n][j]);
                    if (row < R) {
                        const unsigned ch = 128u * pn + cl;
                        *(u32x4*)(U + ((unsigned)row * 512u + ch)) = pack8(uu[0], uu[1]);
                        unsigned co = 0xffffffffu;
                        if (row < RP) { const unsigned t = row & (SEQ - 1); if (t >= SEQ - 30) co = (unsigned)O_CVP + ((l * BATCH + ((unsigned)row >> 11)) * 30u + (t - (SEQ - 30))) * D_A + ch; }
                        else { const unsigned sr = row - RP; co = (unsigned)O_CVS + ((l * DEC_BATCH + (sr >> 2)) * 30u + 26u + (sr & 3u)) * D_A + ch; }
                        if (co != 0xffffffffu) { *(f32x4*)(out + co) = uu[0]; *(f32x4*)(out + co + 4) = uu[1]; }
                    } asm volatile("" ::: "memory"); __builtin_amdgcn_sched_barrier(0); }
        } else if (pn >= 6 && pn <= 10) {
            int gsel = 0; bool do_norm = false, do_rope = false, has_dst = false; unsigned dsto = 0; int ld = 0, col = 0; int fsel = 0;
            if (pn < 8) { gsel = 1; do_norm = true; do_rope = true; has_dst = true; dsto = (unsigned)(A_Q / 2); ld = 512; col = (4 * (pn - 6) + wc) * 64; }
            else if (pn == 8) { if (wc < 2) { gsel = 2; do_norm = true; do_rope = true; has_dst = true; dsto = (unsigned)(A_K / 2); ld = 128; col = wc * 64; fsel = 1; }
                                else { has_dst = true; dsto = (unsigned)(A_V / 2); ld = 128; col = (wc - 2) * 64; fsel = 2; } }
            else if (pn == 9) { do_rope = true; has_dst = true; dsto = (unsigned)(A_QI / 2); ld = 256; col = wc * 64; }
            else { if (wc == 0) { do_norm = true; do_rope = true; has_dst = true; dsto = (unsigned)(A_KI / 2); ld = 64; col = 0; fsel = 3; } }
            bf16_t* const wsb = (bf16_t*)ws;
            if (pn == 10 && wc == 1) {
                if (fq == 0) { float* WI = (float*)(ws + A_WI);
#pragma unroll
                    for (int ai = 0; ai < 2; ++ai)
#pragma unroll
                        for (int m = 0; m < 4; ++m) { int row = rbase + ai * 128 + m * 16; asm volatile("" : "+v"(row));     if (row < R) *(f32x4*)(WI + (unsigned)row * 4u) = acc[ai][0][m][0]; } }
            } else if (has_dst) {
                const float* rope = (const float*)(ws + WS_ROPE); const float* gain = gsel == 1 ? a->q_norm_g + l * 64 : a->k_norm_g + l * 64;
#pragma unroll
                for (int ai = 0; ai < 2; ++ai)
#pragma unroll
                    for (int m = 0; m < 4; ++m) { int row = rbase + ai * 128 + m * 16; asm volatile("" : "+v"(row));
                        f32x4 x1[2] = {acc[ai][0][m][0], acc[ai][0][m][1]}, x2[2] = {acc[ai][1][m][0], acc[ai][1][m][1]};
                        if (do_norm) { float ss = 0.f;
#pragma unroll
                            for (int n = 0; n < 2; ++n)
#pragma unroll
                                for (int j = 0; j < 4; ++j) ss += x1[n][j] * x1[n][j] + x2[n][j] * x2[n][j];
                            ss += __shfl_xor(ss, 16); ss += __shfl_xor(ss, 32);
                            const float r = rsqrtf(ss * (1.f / 64.f) + EPS);
#pragma unroll
                            for (int n = 0; n < 2; ++n) { f32x4 g1 = (f32x4){1.f, 1.f, 1.f, 1.f}, g2 = g1;
                                if (gsel) { g1 = *(const f32x4*)(gain + 8 * fq + 4 * n); g2 = *(const f32x4*)(gain + 32 + 8 * fq + 4 * n); }
                                x1[n] = x1[n] * r * g1; x2[n] = x2[n] * r * g2; } }
#pragma unroll
                        for (int n = 0; n < 2; ++n) {
                            f32x4 o1 = x1[n], o2 = x2[n];
                            if (do_rope) { const float* rp = rope + ((unsigned)rope_slot(row) * 64u + 16u * fq + 8u * n); const f32x4 t0 = *(const f32x4*)rp, t1 = *(const f32x4*)(rp + 4);
                                const f32x4 cs = (f32x4){t0[0], t0[2], t1[0], t1[2]}, sn = (f32x4){t0[1], t0[3], t1[1], t1[3]};
                                o1 = x1[n] * cs - x2[n] * sn; o2 = x2[n] * cs + x1[n] * sn; }
                            if (row < R) {
                                const unsigned o = dsto + (unsigned)row * (unsigned)ld + (unsigned)col + 8u * fq + 4u * n;
                                typedef unsigned u32x2e __attribute__((ext_vector_type(2)));
                                *(u32x2e*)(wsb + o) = (u32x2e){pg8::cvt_pk_bf16(o1[0], o1[1]), pg8::cvt_pk_bf16(o1[2], o1[3])};
                                *(u32x2e*)(wsb + o + 32) = (u32x2e){pg8::cvt_pk_bf16(o2[0], o2[1]), pg8::cvt_pk_bf16(o2[2], o2[3])};
                                if (fsel) { unsigned fo;
                                    if (fsel == 1) fo = row < RP ? (unsigned)O_KP + ((unsigned)l * RP + row) * 128u : (unsigned)O_KS + ((unsigned)l * RS + (row - RP)) * 128u;
                                    else if (fsel == 2) fo = row < RP ? (unsigned)O_VP + ((unsigned)l * RP + row) * 128u : (unsigned)O_VS + ((unsigned)l * RS + (row - RP)) * 128u;
                                    else fo = row < RP ? (unsigned)O_IKP + ((unsigned)l * RP + row) * 64u : (unsigned)O_IKS + ((unsigned)l * RS + (row - RP)) * 64u;
                                    fo += (unsigned)col + 8u * fq + 4u * n;
                                    __builtin_nontemporal_store(o1, (f32x4*)(out + fo)); __builtin_nontemporal_store(o2, (f32x4*)(out + fo + 32)); }
                                if (fsel == 2 && row < RP) {
                                    bf16_t* vt = (bf16_t*)(ws + A_VT) + ((unsigned)((row >> 11) * 2 + (wc - 2)) * 64u + 8u * fq + 4u * n) * (unsigned)SEQ + (unsigned)(row & (SEQ - 1));
#pragma unroll
                                    for (int j = 0; j < 4; ++j) { vt[(unsigned)j * SEQ] = (bf16_t)f2bf(o1[j]); vt[(unsigned)(32 + j) * SEQ] = (bf16_t)f2bf(o2[j]); } } }
                            __builtin_amdgcn_sched_barrier(0);
                        }
                        asm volatile("" ::: "memory"); __builtin_amdgcn_sched_barrier(0); }
            }
        } else if (pn == 15 || pn == 16) {
            float* LF = (float*)(ws + A_LF); bf16_t* KK = (bf16_t*)(ws + A_KK); const float* lbw = (const float*)(ws + WS_LB) + l * C_FDIM;
#pragma unroll
            for (int ai = 0; ai < 2; ++ai)
#pragma unroll
                for (int m = 0; m < 4; ++m) { int row = rbase + ai * 128 + m * 16; asm volatile("" : "+v"(row));
#pragma unroll
                    for (int bj = 0; bj < 2; ++bj) { f32x4 lf[2], kk[2];
#pragma unroll
                        for (int n = 0; n < 2; ++n) { const f32x4 lbv = *(const f32x4*)(lbw + 256 * (pn - 15) + 128 * bj + cl + 4 * n);
#pragma unroll
                            for (int j = 0; j < 4; ++j) { const float fx = acc[ai][bj][m][n][j], lb = lbv[j];
                                const float e = __expf(-fabsf(fx)), r = __builtin_amdgcn_rcpf(1.f + e), er = e * r;
                                const float sp = fx >= 0.f ? r : er, sm = fx >= 0.f ? er : r;
                                lf[n][j] = __logf(fmaxf(lb, 1e-30f) + (1.f - lb) * sp); kk[n][j] = (1.f - lb) * sm; } }
                        if (row < R) { const unsigned o = (unsigned)row * 512u + 256u * (pn - 15) + 128u * bj + cl;
                            *(f32x4*)(LF + o) = lf[0]; *(f32x4*)(LF + o + 4) = lf[1]; *(u32x4*)(KK + o) = pack8(kk[0], kk[1]); } } __builtin_amdgcn_sched_barrier(0); }
        } else {
            bf16_t* dst; int ld, col0, act;
            if (pn < 6) { dst = (bf16_t*)(ws + A_AG); ld = 512; col0 = 256 * (pn - 4); act = 1; }
            else if (pn < 13) { dst = (bf16_t*)(ws + A_BG); ld = 512; col0 = 256 * (pn - 11); act = 1; }
            else if (pn < 15) { dst = (bf16_t*)(ws + A_CQ); ld = 512; col0 = 256 * (pn - 13); act = 1; }
            else if (pn < 19) { dst = (bf16_t*)(ws + A_CI); ld = 512; col0 = 256 * (pn - 17); act = 0; }
            else if (pn < 21) { dst = (bf16_t*)(ws + A_CG); ld = 512; col0 = 256 * (pn - 19); act = 1; }
            else if (pn < 25) { dst = (bf16_t*)(ws + A_GA); ld = 1024; col0 = 256 * (pn - 21); act = 2; }
            else if (pn < 29) { dst = (bf16_t*)(ws + A_GB); ld = 1024; col0 = 256 * (pn - 25); act = 2; }
            else { dst = (bf16_t*)(ws + A_GC); ld = 1024; col0 = 256 * (pn - 29); act = 2; }
#pragma unroll
            for (int ai = 0; ai < 2; ++ai)
#pragma unroll
                for (int m = 0; m < 4; ++m) { int row = rbase + ai * 128 + m * 16; asm volatile("" : "+v"(row));
#pragma unroll
                    for (int bj = 0; bj < 2; ++bj) { f32x4 v[2];
#pragma unroll
                        for (int n = 0; n < 2; ++n)
#pragma unroll
                            for (int j = 0; j < 4; ++j) { const float x = acc[ai][bj][m][n][j]; const float sg = fsig(x); v[n][j] = act == 0 ? x : (act == 1 ? x * sg : sg); }
                        if (row < R) *(u32x4*)(dst + ((unsigned)row * (unsigned)ld + (unsigned)col0 + 128u * bj + cl)) = pack8(v[0], v[1]); } __builtin_amdgcn_sched_barrier(0); }
        }
    }
};
constexpr int CW_HGE = 12416;
constexpr int HG_EARLY = 7;
struct InOrder : pg8::StaticOrder {
    unsigned* ctr;
    __device__ __forceinline__ bool next(int i, pg8::Unit& u) const {
        if (G != 256) return pg8::StaticOrder::next(i, u);
        if (c >= 224) { if (i >= 7) return false; return pg8::StaticOrder::next(i, u); }
        if (i == 8 && c >= 97 && c < 129) { InOrder t = *this; t.c = 224 + (c - 97); return t.pg8::StaticOrder::next(7, u); }
        return pg8::StaticOrder::next(i, u);
    }
    __device__ __forceinline__ void done(const pg8::Unit&, int ui) const {
        if (ui == 5) {
            asm volatile("s_waitcnt vmcnt(0)" ::: "memory");
            __builtin_amdgcn_s_barrier();
            if (threadIdx.x == 0) { __builtin_amdgcn_fence(__ATOMIC_RELEASE, "agent"); asm volatile("s_waitcnt vmcnt(0)" ::: "memory"); (void)__hip_atomic_fetch_add(ctr, 1u, __ATOMIC_RELAXED, __HIP_MEMORY_SCOPE_AGENT); }
        }
    }
};
__device__ __forceinline__ void phase_inproj(KA a, const Ctx& c, int l) {
    pg8::Gemm g{(const bf16_t*)(a->ws + WS_H), (const bf16_t*)(a->ws + WS_WTIN) + (size_t)l * NPAD * 1024, RPAD, NPAD, 1024};
    InOrder S; S.init(RPAD, NPAD, c.nblk, c.bid); S.ctr = (unsigned*)(a->ws + WS_CTL) + CW_HGE + 64 * l;
    EpiIn E{a, l};
    pg8::gemm_phase<EpiIn, InOrder, true, true>(c.lds_las, g, S, E, c.tid);
}

__device__ __forceinline__ void mix_conv(KA a, const Ctx& c, int l) {
    const bf16_t* U = (const bf16_t*)(a->ws + A_U); const bf16_t* AG = (const bf16_t*)(a->ws + A_AG); bf16_t* YA = (bf16_t*)(a->ws + A_YA);
    const float* wdw = a->w_dw + (size_t)l * CONV_W * D_A; const float* bdw = a->b_dw + l * D_A; const float* lg = a->ln_g + l * D_A; const float* lb = a->ln_b + l * D_A;
    float* red = (float*)c.lds;
    const int ch = c.tid;
    for (int row = c.bid; row < R; row += c.nblk) {
        float y = bdw[ch];
        if (row < RP) {
            const int t = row % SEQ;
            for (int j = 0; j < CONV_W; ++j) { const int ft = t + j - 30; if (ft >= 0) y += wdw[j * D_A + ch] * LD(U, (size_t)(row - t + ft) * 512 + ch); }
        } else {
            const int b = (row - RP) / DEC_SEQ, t = (row - RP) % DEC_SEQ; const float* buf = a->state_conv + ((size_t)l * DEC_BATCH + b) * 30 * D_A;
            for (int j = 0; j < CONV_W; ++j) { const int f = t + j; const float v = f < 30 ? buf[f * D_A + ch] : LD(U, (size_t)(RP + b * DEC_SEQ + (f - 30)) * 512 + ch); y += wdw[j * D_A + ch] * v; }
        }
        const float mu = block_sum(c, y, red) * (1.f / D_A);
        const float d = y - mu;
        const float var = block_sum(c, d * d, red) * (1.f / D_A);
        const float ln = d * rsqrtf(var + EPS) * lg[ch] + lb[ch];
        YA[(size_t)row * 512 + ch] = (bf16_t)f2bf(silu_f(ln) * LD(AG, (size_t)row * 512 + ch));
    }
    const int gtid = c.bid * NT + c.tid, gn = c.nblk * NT;
    for (int i = gtid; i < DEC_BATCH * 26 * D_A; i += gn) { const int chn = i % D_A, j = (i / D_A) % 26, b = i / (D_A * 26);
        a->out[O_CVS + (((size_t)l * DEC_BATCH + b) * 30 + j) * D_A + chn] = a->state_conv[(((size_t)l * DEC_BATCH + b) * 30 + j + DEC_SEQ) * D_A + chn]; }
}

__device__ __forceinline__ void mix_hgrn(KA a, const Ctx& c, int l, int it_first, int it_end) {
    const bf16_t* CQ = (const bf16_t*)(a->ws + A_CQ); const float* LF = (const float*)(a->ws + A_LF); const bf16_t* KK = (const bf16_t*)(a->ws + A_KK);
    const bf16_t* CI = (const bf16_t*)(a->ws + A_CI); const bf16_t* CG = (const bf16_t*)(a->ws + A_CG); bf16_t* YC = (bf16_t*)(a->ws + A_YC);
    const float* cg = a->c_norm_g + l * C_VDIM;
    float* sq = (float*)c.lds; float* sf = sq + 128; float* sk = sf + 128; float* part = sk + 128;   float* red = part + 512;
    const int v = c.tid & 127, dg = c.tid >> 7;
    const int nitems = (BATCH + DEC_BATCH) * C_HEADS;
    (void)nitems;
    for (int it = it_first; it < it_end; it += c.nblk) {
        const int bb = it / C_HEADS, h = it % C_HEADS; const bool pr = bb < BATCH;
        const int T = pr ? SEQ : DEC_SEQ; const int row0 = pr ? bb * SEQ : RP + (bb - BATCH) * DEC_SEQ;
        float S[32];
        if (pr) {
#pragma unroll
            for (int j = 0; j < 32; ++j) S[j] = 0.f;
        } else {
            const float* s0 = a->state_hgrn + (((size_t)l * DEC_BATCH + (bb - BATCH)) * C_HEADS + h) * C_KDIM * C_VDIM;
#pragma unroll
            for (int j = 0; j < 32; ++j) S[j] = s0[(size_t)(dg * 32 + j) * C_VDIM + v];
        }
        for (int t = 0; t < T; ++t) {
            const size_t ro = (size_t)(row0 + t) * 512 + h * 128;
            __syncthreads();
            if (c.tid < 128) { sq[c.tid] = LD(CQ, ro + c.tid); sf[c.tid] = expf(LF[ro + c.tid]); sk[c.tid] = LD(KK, ro + c.tid); }
            const float iv = LD(CI, ro + v);
            __syncthreads();
            float p = 0.f;
#pragma unroll
            for (int j = 0; j < 32; ++j) { const int d = dg * 32 + j; S[j] = sf[d] * S[j] + sk[d] * iv; p += S[j] * sq[d]; }
            part[dg * 128 + v] = p;
            __syncthreads();
            float o = 0.f, ss = 0.f;
            if (c.tid < 128) { o = part[v] + part[128 + v] + part[256 + v] + part[384 + v]; ss = wave_sum(o * o); if (c.lane == 0) red[c.wave] = ss; }
            __syncthreads();
            if (c.tid < 128) { const float tot = red[0] + red[1]; YC[ro + v] = (bf16_t)f2bf(o * rsqrtf(tot * (1.f / 128.f) + EPS) * cg[v] * LD(CG, ro + v)); }
        }
        float* so = pr ? a->out + O_HGP + (((size_t)l * BATCH + bb) * C_HEADS + h) * C_KDIM * C_VDIM : a->out + O_HGS + (((size_t)l * DEC_BATCH + (bb - BATCH)) * C_HEADS + h) * C_KDIM * C_VDIM;
#pragma unroll
        for (int j = 0; j < 32; ++j) so[(size_t)(dg * 32 + j) * C_VDIM + v] = S[j];
    }
}

__device__ __forceinline__ unsigned fkey(float f) { const unsigned u = __float_as_uint(f); return (u & 0x80000000u) ? ~u : (u | 0x80000000u); }
__device__ __forceinline__ void mix_dsa(KA a, const Ctx& c, int l, int row_first, int row_end) {
    const bf16_t* Q = (const bf16_t*)(a->ws + A_Q); const bf16_t* Kb = (const bf16_t*)(a->ws + A_K); const bf16_t* Vb = (const bf16_t*)(a->ws + A_V);
    const bf16_t* QI = (const bf16_t*)(a->ws + A_QI); const bf16_t* KI = (const bf16_t*)(a->ws + A_KI); const float* WI = (const float*)(a->ws + A_WI);
    const bf16_t* BG = (const bf16_t*)(a->ws + A_BG); bf16_t* YB = (bf16_t*)(a->ws + A_YB);
    const float* ck = a->cache_k + (size_t)l * N_POOL * PAGE * KV_DIM; const float* cv = a->cache_v + (size_t)l * N_POOL * PAGE * KV_DIM;
    const float* cki = a->cache_idx_k + (size_t)l * N_POOL * PAGE * IDX_DIM;
    unsigned* keys = (unsigned*)c.lds;
    float* sqi = (float*)(keys + 8256);
    float* sq = sqi + 256;
    int* sel = (int*)(sq + 512);
    float* att = (float*)(sel + 256);
    int* cnt = (int*)(att + 2048);
    float* red = (float*)(cnt + 4);
    int* spt = (int*)(red + 16);
    int* prow = spt + 64;
    int* newslot = prow + 256;
    for (int row = row_first; row < row_end; row += c.nblk) {
        const bool pr = row < RP; const int b = pr ? row / SEQ : (row - RP) / DEC_SEQ, t = pr ? row % SEQ : (row - RP) % DEC_SEQ;
        const int nkeys = pr ? t + 1 : PAST_LEN + t + 1;
        const int* pt = a->page_table + b * N_PAGES;
        __syncthreads();
        if (c.tid < 256) sqi[c.tid] = LD(QI, (unsigned)row * 256u + c.tid);
        sq[c.tid] = LD(Q, (unsigned)row * 512u + c.tid) * 0.125f;
        if (c.tid == 0) cnt[0] = 0;
        if (c.tid < N_PAGES) spt[c.tid] = pt[c.tid];
        if (c.tid < 4) newslot[c.tid] = -1;
        const float w0 = WI[(unsigned)row * 4u + 0], w1 = WI[(unsigned)row * 4u + 1], w2 = WI[(unsigned)row * 4u + 2], w3 = WI[(unsigned)row * 4u + 3];
        __syncthreads();
        if (!pr) {
            const int c16 = c.lane & 15, g = c.lane >> 4;
            bf16x8_t Aq[2];
#pragma unroll
            for (int ks = 0; ks < 2; ++ks) { Aq[ks] = (bf16x8_t){0, 0, 0, 0, 0, 0, 0, 0}; if (c16 < 4) Aq[ks] = *(const bf16x8_t*)(QI + ((unsigned)row * 256u + c16 * 64 + 32 * ks + 8 * g)); }
#pragma unroll 1
            for (int nt0 = c.wave; nt0 < PAST_LEN / 16; nt0 += 64) {
                float4 kr[8][4];
#pragma unroll
                for (int q = 0; q < 8; ++q) { const int s = 16 * (nt0 + 8 * q) + c16;
                    const float* kp = cki + ((size_t)spt[s >> 7] * PAGE + (s & (PAGE - 1))) * 64 + 8 * g;
                    kr[q][0] = *(const float4*)kp; kr[q][1] = *(const float4*)(kp + 4); kr[q][2] = *(const float4*)(kp + 32); kr[q][3] = *(const float4*)(kp + 36); }
#pragma unroll
                for (int q = 0; q < 8; ++q) { const int s = 16 * (nt0 + 8 * q) + c16;
                    const u32x4 b0 = (u32x4){pg8::cvt_pk_bf16(kr[q][0].x, kr[q][0].y), pg8::cvt_pk_bf16(kr[q][0].z, kr[q][0].w), pg8::cvt_pk_bf16(kr[q][1].x, kr[q][1].y), pg8::cvt_pk_bf16(kr[q][1].z, kr[q][1].w)};
                    const u32x4 b1 = (u32x4){pg8::cvt_pk_bf16(kr[q][2].x, kr[q][2].y), pg8::cvt_pk_bf16(kr[q][2].z, kr[q][2].w), pg8::cvt_pk_bf16(kr[q][3].x, kr[q][3].y), pg8::cvt_pk_bf16(kr[q][3].z, kr[q][3].w)};
                    f32x4 acc = (f32x4){0.f, 0.f, 0.f, 0.f};
                    acc = __builtin_amdgcn_mfma_f32_16x16x32_bf16(Aq[0], __builtin_bit_cast(bf16x8_t, b0), acc, 0, 0, 0);
                    acc = __builtin_amdgcn_mfma_f32_16x16x32_bf16(Aq[1], __builtin_bit_cast(bf16x8_t, b1), acc, 0, 0, 0);
                    if (g == 0) { float sc = fmaxf(acc[0] * 0.125f, 0.f) * w0;
                        sc += fmaxf(acc[1] * 0.125f, 0.f) * w1; sc += fmaxf(acc[2] * 0.125f, 0.f) * w2; sc += fmaxf(acc[3] * 0.125f, 0.f) * w3;
                        keys[s] = fkey(sc * 0.5f); } }
            }
        }
        for (int s = (pr ? 0 : PAST_LEN) + c.tid; s < nkeys; s += NT) {
            const float* kpf = nullptr; const bf16_t* kpb = nullptr;
            if (pr) kpb = KI + (size_t)(b * SEQ + s) * 64;
            else if (s < PAST_LEN) kpf = cki + ((size_t)spt[s / PAGE] * PAGE + (s % PAGE)) * 64;
            else kpb = KI + (size_t)(RP + b * DEC_SEQ + (s - PAST_LEN)) * 64;
            float d0 = 0.f, d1 = 0.f, d2 = 0.f, d3 = 0.f;
            if (kpf) {
                float4 kq[16];
#pragma unroll
                for (int q = 0; q < 16; ++q) kq[q] = ((const float4*)kpf)[q];
#pragma unroll
                for (int q = 0; q < 16; ++q) { const int j = 4 * q;
                    const float4 q0 = *(const float4*)(sqi + j), q1 = *(const float4*)(sqi + 64 + j), q2 = *(const float4*)(sqi + 128 + j), q3 = *(const float4*)(sqi + 192 + j);
                    d0 += q0.x * kq[q].x + q0.y * kq[q].y + q0.z * kq[q].z + q0.w * kq[q].w;
                    d1 += q1.x * kq[q].x + q1.y * kq[q].y + q1.z * kq[q].z + q1.w * kq[q].w;
                    d2 += q2.x * kq[q].x + q2.y * kq[q].y + q2.z * kq[q].z + q2.w * kq[q].w;
                    d3 += q3.x * kq[q].x + q3.y * kq[q].y + q3.z * kq[q].z + q3.w * kq[q].w; }
            } else {
#pragma unroll 1
                for (int j = 0; j < 64; j += 8) { float kv[8]; ld8(kpb + j, kv);
#pragma unroll
                    for (int q = 0; q < 8; ++q) { d0 += sqi[j + q] * kv[q]; d1 += sqi[64 + j + q] * kv[q]; d2 += sqi[128 + j + q] * kv[q]; d3 += sqi[192 + j + q] * kv[q]; } }
            }
            float sc = fmaxf(d0 * 0.125f, 0.f) * w0;
            sc += fmaxf(d1 * 0.125f, 0.f) * w1; sc += fmaxf(d2 * 0.125f, 0.f) * w2; sc += fmaxf(d3 * 0.125f, 0.f) * w3;
            keys[s] = fkey(sc * 0.5f);
        }
        __syncthreads();
        int nsel;
        if (nkeys <= TOPK) {
            if (c.tid < nkeys) sel[c.tid] = c.tid;
            nsel = nkeys;
        } else {
            unsigned* HS = (unsigned*)(att);
            unsigned prefix = 0u; int need = TOPK;
#pragma unroll 1
            for (int pass = 0; pass < 4; ++pass) {
                const int shift = 24 - 8 * pass; const unsigned himask = pass == 0 ? 0u : (0xffffffffu << (shift + 8));
                __syncthreads();
                for (int i = c.tid; i < 2048; i += NT) HS[i] = 0u;
                __syncthreads();
                for (int s = c.tid; s < nkeys; s += NT) { const unsigned kk = keys[s]; if ((kk & himask) == prefix) atomicAdd(&HS[c.wave * 256 + ((kk >> shift) & 255u)], 1u); }
                __syncthreads();
                int c4[4];
#pragma unroll
                for (int q = 0; q < 4; ++q) { unsigned t = 0u;
#pragma unroll
                    for (int w8 = 0; w8 < 8; ++w8) t += HS[w8 * 256 + 4 * c.lane + q];
                    c4[q] = (int)t; }
                const int ssum = c4[0] + c4[1] + c4[2] + c4[3];
                int pre = ssum;
                pre += __builtin_amdgcn_update_dpp(0, pre, 0x111, 0xf, 0xf, false);
                pre += __builtin_amdgcn_update_dpp(0, pre, 0x112, 0xf, 0xf, false);
                pre += __builtin_amdgcn_update_dpp(0, pre, 0x114, 0xf, 0xf, false);
                pre += __builtin_amdgcn_update_dpp(0, pre, 0x118, 0xf, 0xf, false);
                pre += __builtin_amdgcn_update_dpp(0, pre, 0x142, 0xa, 0xf, false);
                pre += __builtin_amdgcn_update_dpp(0, pre, 0x143, 0xc, 0xf, false);
                const int total = __builtin_amdgcn_readlane(pre, 63);
                const int suf = total - pre + ssum;
                const unsigned long long m = __ballot(suf >= need);
                const int L = 63 - __clzll(m);
                const int above = L < 63 ? __builtin_amdgcn_readlane(suf, (L + 1) & 63) : 0;
                const int cy = __builtin_amdgcn_readlane(c4[1], L), cz = __builtin_amdgcn_readlane(c4[2], L), cw = __builtin_amdgcn_readlane(c4[3], L);
                int q, ab;
                if (above + cw >= need) { q = 3; ab = above; } else if (above + cw + cz >= need) { q = 2; ab = above + cw; } else if (above + cw + cz + cy >= need) { q = 1; ab = above + cw + cz; } else { q = 0; ab = above + cw + cz + cy; }
                prefix |= (unsigned)(4 * L + q) << shift; need -= ab;
            }
            __syncthreads();
            for (int s = c.tid; s < nkeys; s += NT) if (keys[s] > prefix) { const int p = atomicAdd(&cnt[0], 1); sel[p] = s; }
            __syncthreads();
            const int ngt = cnt[0];
            if (c.wave == 0) {
                int taken = ngt;
                for (int s0 = 0; s0 < nkeys && taken < TOPK; s0 += 64) {
                    const int s = s0 + c.lane; const bool tie = (s < nkeys) && (keys[s] == prefix);
                    const unsigned long long m = __ballot(tie);
                    const int before = __popcll(m & ((1ull << c.lane) - 1ull));
                    if (tie && taken + before < TOPK) sel[taken + before] = s;
                    taken += __popcll(m);
                }
            }
            nsel = TOPK;
        }
        __syncthreads();
        {
            const int slot = c.tid & 255, n = c.tid >> 8;
            if (slot < nsel) {
                const int s = sel[slot]; const float* kpf = nullptr; const bf16_t* kpb = nullptr; int pw = -1, ns = -1;
                if (pr) { kpb = Kb + (size_t)(b * SEQ + s) * 128; }
                else if (s < PAST_LEN) { const int rr = spt[s / PAGE] * PAGE + (s % PAGE); kpf = ck + (size_t)rr * 128; pw = rr; }
                else { const int rr = RP + b * DEC_SEQ + (s - PAST_LEN); kpb = Kb + (size_t)rr * 128; ns = s - PAST_LEN; }
                if (n == 0) { prow[slot] = pw; if (ns >= 0) newslot[ns] = slot; }
                float kv[64];
                if (kpb) {
#pragma unroll
                    for (int i = 0; i < 8; ++i) { float t8[8]; ld8(kpb + 64 * n + 8 * i, t8);
#pragma unroll
                        for (int e = 0; e < 8; ++e) kv[8 * i + e] = t8[e]; }
                } else {
#pragma unroll
                    for (int i = 0; i < 16; ++i) { const float4 t4 = *(const float4*)(kpf + 64 * n + 4 * i); kv[4 * i] = t4.x; kv[4 * i + 1] = t4.y; kv[4 * i + 2] = t4.z; kv[4 * i + 3] = t4.w; }
                }
#pragma unroll
                for (int h = 0; h < 4; ++h) { const float* qp = sq + (4 * n + h) * 64; float dd = 0.f;
#pragma unroll
                    for (int i = 0; i < 16; ++i) { const float4 q4 = *(const float4*)(qp + 4 * i); dd += q4.x * kv[4 * i] + q4.y * kv[4 * i + 1] + q4.z * kv[4 * i + 2] + q4.w * kv[4 * i + 3]; }
                    att[(4 * n + h) * 256 + slot] = dd; }
            }
        }
        __syncthreads();
        {
            const int h = c.wave; float mx = -3.0e38f;
            for (int j = c.lane; j < nsel; j += 64) mx = fmaxf(mx, att[h * 256 + j]);
            mx = wave_max(mx);
            float sum = 0.f;
            for (int j = c.lane; j < nsel; j += 64) { const float e = __expf(att[h * 256 + j] - mx); att[h * 256 + j] = e; sum += e; }
            sum = wave_sum(sum);
            const float inv = 1.f / sum;
            for (int j = c.lane; j < nsel; j += 64) att[h * 256 + j] *= inv;
        }
        __syncthreads();
        {
            const int h = c.wave, n = h >> 2, ks = c.lane >> 4, d4 = c.lane & 15;
            float o0 = 0.f, o1 = 0.f, o2 = 0.f, o3 = 0.f;
#pragma unroll 1
            for (int j0 = 0; j0 < 256; j0 += 64) {
                float4 vv[16]; float pw[16];
#pragma unroll
                for (int q = 0; q < 16; ++q) { const int j = j0 + 4 * q + ks; const int rr = j < nsel ? prow[j] : -1; const bool ok = rr >= 0;
                    pw[q] = ok ? att[h * 256 + j] : 0.f;
                    vv[q] = *(const float4*)(cv + (size_t)(ok ? rr : 0) * 128 + n * 64 + 4 * d4); }
#pragma unroll
                for (int q = 0; q < 16; ++q) { o0 += pw[q] * vv[q].x; o1 += pw[q] * vv[q].y; o2 += pw[q] * vv[q].z; o3 += pw[q] * vv[q].w; }
            }
            if (ks == 0) {
#pragma unroll
                for (int tt = 0; tt < DEC_SEQ; ++tt) { const int jn = newslot[tt]; if (jn >= 0) { const float wn = att[h * 256 + jn]; const bf16_t* vp = Vb + (size_t)(RP + b * DEC_SEQ + tt) * 128 + n * 64 + 4 * d4;
                    o0 += wn * bf2f(vp[0]); o1 += wn * bf2f(vp[1]); o2 += wn * bf2f(vp[2]); o3 += wn * bf2f(vp[3]); } }
            }
            o0 += __shfl_xor(o0, 16); o1 += __shfl_xor(o1, 16); o2 += __shfl_xor(o2, 16); o3 += __shfl_xor(o3, 16);
            o0 += __shfl_xor(o0, 32); o1 += __shfl_xor(o1, 32); o2 += __shfl_xor(o2, 32); o3 += __shfl_xor(o3, 32);
            if (ks == 0) { const unsigned e = (unsigned)row * 512u + h * 64 + 4 * d4;
                YB[e] = (bf16_t)f2bf(o0 * LD(BG, e)); YB[e + 1] = (bf16_t)f2bf(o1 * LD(BG, e + 1)); YB[e + 2] = (bf16_t)f2bf(o2 * LD(BG, e + 2)); YB[e + 3] = (bf16_t)f2bf(o3 * LD(BG, e + 3)); }
        }
    }
}

constexpr int DSA_TPI = 2;
__device__ __forceinline__ void mix_dsa4(KA a, const Ctx& c, int l, int b, int tp) {
    const bf16_t* Q = (const bf16_t*)(a->ws + A_Q); const bf16_t* Kb = (const bf16_t*)(a->ws + A_K); const bf16_t* Vb = (const bf16_t*)(a->ws + A_V);
    const bf16_t* QI = (const bf16_t*)(a->ws + A_QI); const bf16_t* KI = (const bf16_t*)(a->ws + A_KI); const float* WI = (const float*)(a->ws + A_WI);
    const bf16_t* BG = (const bf16_t*)(a->ws + A_BG); bf16_t* YB = (bf16_t*)(a->ws + A_YB);
    const float* ck = a->cache_k + (size_t)l * N_POOL * PAGE * KV_DIM; const float* cv = a->cache_v + (size_t)l * N_POOL * PAGE * KV_DIM;
    const float* cki = a->cache_idx_k + (size_t)l * N_POOL * PAGE * IDX_DIM;
    unsigned* keys4 = (unsigned*)c.lds;
    float* sqi = (float*)(keys4 + DSA_TPI * 8256);
    float* sq = sqi + 256;
    int* sel = (int*)(sq + 512);
    float* att = (float*)(sel + 256);
    int* cnt = (int*)(att + 2048);
    float* red = (float*)(cnt + 4);
    int* spt = (int*)(red + 16);
    int* prow = spt + 64;
    int* newslot = prow + 256;
    static_assert((DSA_TPI * 8256 + 256 + 512 + 256 + 2048 + 4 + 16 + 64 + 256 + 4) * 4 <= LDS_BYTES - 128, "mix_dsa4 LDS carve");
    (void)red;
    const bool pr = false;
    __syncthreads();
    if (c.tid < N_PAGES) spt[c.tid] = a->page_table[b * N_PAGES + c.tid];
    __syncthreads();
    {
        const int c16 = c.lane & 15, g = c.lane >> 4;
        bf16x8_t Aq[2]; float wq[4];
#pragma unroll
        for (int ks = 0; ks < 2; ++ks) { Aq[ks] = (bf16x8_t){0, 0, 0, 0, 0, 0, 0, 0}; if ((c16 >> 2) < DSA_TPI) Aq[ks] = *(const bf16x8_t*)(QI + ((unsigned)(RP + b * DEC_SEQ + DSA_TPI * tp + (c16 >> 2)) * 256u + (c16 & 3) * 64 + 32 * ks + 8 * g)); }
        { const int gt = g < DSA_TPI ? g : 0; const f32x4 w4 = *(const f32x4*)(WI + (unsigned)(RP + b * DEC_SEQ + DSA_TPI * tp + gt) * 4u); wq[0] = w4[0]; wq[1] = w4[1]; wq[2] = w4[2]; wq[3] = w4[3]; }
        float4 ka_[4][4], kb_[4][4];
#define SD_LD(set_, j0_) do { _Pragma("unroll") for (int q = 0; q < 4; ++q) { const int s_ = 16 * (c.wave + 8 * ((j0_) + q)) + c16; \
            const float* kp_ = cki + ((size_t)spt[s_ >> 7] * PAGE + (s_ & (PAGE - 1))) * 64 + 8 * g; \
            set_[q][0] = *(const float4*)kp_; set_[q][1] = *(const float4*)(kp_ + 4); set_[q][2] = *(const float4*)(kp_ + 32); set_[q][3] = *(const float4*)(kp_ + 36); } } while (0)
#define SD_CP(set_, j0_) do { _Pragma("unroll") for (int q = 0; q < 4; ++q) { const int s_ = 16 * (c.wave + 8 * ((j0_) + q)) + c16; \
            const u32x4 b0_ = (u32x4){pg8::cvt_pk_bf16(set_[q][0].x, set_[q][0].y), pg8::cvt_pk_bf16(set_[q][0].z, set_[q][0].w), pg8::cvt_pk_bf16(set_[q][1].x, set_[q][1].y), pg8::cvt_pk_bf16(set_[q][1].z, set_[q][1].w)}; \
            const u32x4 b1_ = (u32x4){pg8::cvt_pk_bf16(set_[q][2].x, set_[q][2].y), pg8::cvt_pk_bf16(set_[q][2].z, set_[q][2].w), pg8::cvt_pk_bf16(set_[q][3].x, set_[q][3].y), pg8::cvt_pk_bf16(set_[q][3].z, set_[q][3].w)}; \
            f32x4 acc_ = (f32x4){0.f, 0.f, 0.f, 0.f}; \
            acc_ = __builtin_amdgcn_mfma_f32_16x16x32_bf16(Aq[0], __builtin_bit_cast(bf16x8_t, b0_), acc_, 0, 0, 0); \
            acc_ = __builtin_amdgcn_mfma_f32_16x16x32_bf16(Aq[1], __builtin_bit_cast(bf16x8_t, b1_), acc_, 0, 0, 0); \
            float sc_ = fmaxf(acc_[0] * 0.125f, 0.f) * wq[0]; sc_ += fmaxf(acc_[1] * 0.125f, 0.f) * wq[1]; sc_ += fmaxf(acc_[2] * 0.125f, 0.f) * wq[2]; sc_ += fmaxf(acc_[3] * 0.125f, 0.f) * wq[3]; \
            if (g < DSA_TPI) keys4[g * 8256 + s_] = fkey(sc_ * 0.5f); } } while (0)
        SD_LD(ka_, 0);
#pragma unroll 1
        for (int j0 = 0; j0 < 64; j0 += 8) {
            SD_LD(kb_, j0 + 4);
            SD_CP(ka_, j0);
            { const int jn = j0 + 8 < 64 ? j0 + 8 : 56; SD_LD(ka_, jn); }
            SD_CP(kb_, j0 + 4);
        }
#undef SD_LD
#undef SD_CP
    }
    __syncthreads();
#pragma unroll 1
    for (int tt_ = 0; tt_ < DSA_TPI; ++tt_) {
        const int t = DSA_TPI * tp + tt_, row = RP + b * DEC_SEQ + t, nkeys = PAST_LEN + t + 1;
        unsigned* keys = keys4 + tt_ * 8256;
        __syncthreads();
        if (c.tid < 256) sqi[c.tid] = LD(QI, (unsigned)row * 256u + c.tid);
        sq[c.tid] = LD(Q, (unsigned)row * 512u + c.tid) * 0.125f;
        if (c.tid == 0) cnt[0] = 0;
        if (c.tid < 4) newslot[c.tid] = -1;
        const float w0 = WI[(unsigned)row * 4u + 0], w1 = WI[(unsigned)row * 4u + 1], w2 = WI[(unsigned)row * 4u + 2], w3 = WI[(unsigned)row * 4u + 3];
        __syncthreads();
        for (int s = (pr ? 0 : PAST_LEN) + c.tid; s < nkeys; s += NT) {
            const float* kpf = nullptr; const bf16_t* kpb = nullptr;
            if (pr) kpb = KI + (size_t)(b * SEQ + s) * 64;
            else if (s < PAST_LEN) kpf = cki + ((size_t)spt[s / PAGE] * PAGE + (s % PAGE)) * 64;
            else kpb = KI + (size_t)(RP + b * DEC_SEQ + (s - PAST_LEN)) * 64;
            float d0 = 0.f, d1 = 0.f, d2 = 0.f, d3 = 0.f;
            if (kpf) {
                float4 kq[16];
#pragma unroll
                for (int q = 0; q < 16; ++q) kq[q] = ((const float4*)kpf)[q];
#pragma unroll
                for (int q = 0; q < 16; ++q) { const int j = 4 * q;
                    const float4 q0 = *(const float4*)(sqi + j), q1 = *(const float4*)(sqi + 64 + j), q2 = *(const float4*)(sqi + 128 + j), q3 = *(const float4*)(sqi + 192 + j);
                    d0 += q0.x * kq[q].x + q0.y * kq[q].y + q0.z * kq[q].z + q0.w * kq[q].w;
                    d1 += q1.x * kq[q].x + q1.y * kq[q].y + q1.z * kq[q].z + q1.w * kq[q].w;
                    d2 += q2.x * kq[q].x + q2.y * kq[q].y + q2.z * kq[q].z + q2.w * kq[q].w;
                    d3 += q3.x * kq[q].x + q3.y * kq[q].y + q3.z * kq[q].z + q3.w * kq[q].w; }
            } else {
#pragma unroll 1
                for (int j = 0; j < 64; j += 8) { float kv[8]; ld8(kpb + j, kv);
#pragma unroll
                    for (int q = 0; q < 8; ++q) { d0 += sqi[j + q] * kv[q]; d1 += sqi[64 + j + q] * kv[q]; d2 += sqi[128 + j + q] * kv[q]; d3 += sqi[192 + j + q] * kv[q]; } }
            }
            float sc = fmaxf(d0 * 0.125f, 0.f) * w0;
            sc += fmaxf(d1 * 0.125f, 0.f) * w1; sc += fmaxf(d2 * 0.125f, 0.f) * w2; sc += fmaxf(d3 * 0.125f, 0.f) * w3;
            keys[s] = fkey(sc * 0.5f);
        }
        __syncthreads();
        int nsel;
        if (nkeys <= TOPK) {
            if (c.tid < nkeys) sel[c.tid] = c.tid;
            nsel = nkeys;
        } else {
            unsigned* HS = (unsigned*)(att);
            unsigned prefix = 0u; int need = TOPK;
#pragma unroll 1
            for (int pass = 0; pass < 4; ++pass) {
                const int shift = 24 - 8 * pass; const unsigned himask = pass == 0 ? 0u : (0xffffffffu << (shift + 8));
                __syncthreads();
                for (int i = c.tid; i < 2048; i += NT) HS[i] = 0u;
                __syncthreads();
                for (int s = c.tid; s < nkeys; s += NT) { const unsigned kk = keys[s]; if ((kk & himask) == prefix) atomicAdd(&HS[c.wave * 256 + ((kk >> shift) & 255u)], 1u); }
                __syncthreads();
                int c4[4];
#pragma unroll
                for (int q = 0; q < 4; ++q) { unsigned t = 0u;
#pragma unroll
                    for (int w8 = 0; w8 < 8; ++w8) t += HS[w8 * 256 + 4 * c.lane + q];
                    c4[q] = (int)t; }
                const int ssum = c4[0] + c4[1] + c4[2] + c4[3];
                int pre = ssum;
                pre += __builtin_amdgcn_update_dpp(0, pre, 0x111, 0xf, 0xf, false);
                pre += __builtin_amdgcn_update_dpp(0, pre, 0x112, 0xf, 0xf, false);
                pre += __builtin_amdgcn_update_dpp(0, pre, 0x114, 0xf, 0xf, false);
                pre += __builtin_amdgcn_update_dpp(0, pre, 0x118, 0xf, 0xf, false);
                pre += __builtin_amdgcn_update_dpp(0, pre, 0x142, 0xa, 0xf, false);
                pre += __builtin_amdgcn_update_dpp(0, pre, 0x143, 0xc, 0xf, false);
                const int total = __builtin_amdgcn_readlane(pre, 63);
                const int suf = total - pre + ssum;
                const unsigned long long m = __ballot(suf >= need);
                const int L = 63 - __clzll(m);
                const int above = L < 63 ? __builtin_amdgcn_readlane(suf, (L + 1) & 63) : 0;
                const int cy = __builtin_amdgcn_readlane(c4[1], L), cz = __builtin_amdgcn_readlane(c4[2], L), cw = __builtin_amdgcn_readlane(c4[3], L);
                int q, ab;
                if (above + cw >= need) { q = 3; ab = above; } else if (above + cw + cz >= need) { q = 2; ab = above + cw; } else if (above + cw + cz + cy >= need) { q = 1; ab = above + cw + cz; } else { q = 0; ab = above + cw + cz + cy; }
                prefix |= (unsigned)(4 * L + q) << shift; need -= ab;
            }
            __syncthreads();
            for (int s = c.tid; s < nkeys; s += NT) if (keys[s] > prefix) { const int p = atomicAdd(&cnt[0], 1); sel[p] = s; }
            __syncthreads();
            const int ngt = cnt[0];
            if (c.wave == 0) {
                int taken = ngt;
                for (int s0 = 0; s0 < nkeys && taken < TOPK; s0 += 64) {
                    const int s = s0 + c.lane; const bool tie = (s < nkeys) && (keys[s] == prefix);
                    const unsigned long long m = __ballot(tie);
                    const int before = __popcll(m & ((1ull << c.lane) - 1ull));
                    if (tie && taken + before < TOPK) sel[taken + before] = s;
                    taken += __popcll(m);
                }
            }
            nsel = TOPK;
        }
        __syncthreads();
        {
            const int slot = c.tid & 255, n = c.tid >> 8;
            if (slot < nsel) {
                const int s = sel[slot]; const float* kpf = nullptr; const bf16_t* kpb = nullptr; int pw = -1, ns = -1;
                if (pr) { kpb = Kb + (size_t)(b * SEQ + s) * 128; }
                else if (s < PAST_LEN) { const int rr = spt[s / PAGE] * PAGE + (s % PAGE); kpf = ck + (size_t)rr * 128; pw = rr; }
                else { const int rr = RP + b * DEC_SEQ + (s - PAST_LEN); kpb = Kb + (size_t)rr * 128; ns = s - PAST_LEN; }
                if (n == 0) { prow[slot] = pw; if (ns >= 0) newslot[ns] = slot; }
                float kv[64];
                if (kpb) {
#pragma unroll
                    for (int i = 0; i < 8; ++i) { float t8[8]; ld8(kpb + 64 * n + 8 * i, t8);
#pragma unroll
                        for (int e = 0; e < 8; ++e) kv[8 * i + e] = t8[e]; }
                } else {
#pragma unroll
                    for (int i = 0; i < 16; ++i) { const float4 t4 = *(const float4*)(kpf + 64 * n + 4 * i); kv[4 * i] = t4.x; kv[4 * i + 1] = t4.y; kv[4 * i + 2] = t4.z; kv[4 * i + 3] = t4.w; }
                }
#pragma unroll
                for (int h = 0; h < 4; ++h) { const float* qp = sq + (4 * n + h) * 64; float dd = 0.f;
#pragma unroll
                    for (int i = 0; i < 16; ++i) { const float4 q4 = *(const float4*)(qp + 4 * i); dd += q4.x * kv[4 * i] + q4.y * kv[4 * i + 1] + q4.z * kv[4 * i + 2] + q4.w * kv[4 * i + 3]; }
                    att[(4 * n + h) * 256 + slot] = dd; }
            }
        }
        __syncthreads();
        {
            const int h = c.wave; float mx = -3.0e38f;
            for (int j = c.lane; j < nsel; j += 64) mx = fmaxf(mx, att[h * 256 + j]);
            mx = wave_max(mx);
            float sum = 0.f;
            for (int j = c.lane; j < nsel; j += 64) { const float e = __expf(att[h * 256 + j] - mx); att[h * 256 + j] = e; sum += e; }
            sum = wave_sum(sum);
            const float inv = 1.f / sum;
            for (int j = c.lane; j < nsel; j += 64) att[h * 256 + j] *= inv;
        }
        __syncthreads();
        {
            const int h = c.wave, n = h >> 2, ks = c.lane >> 4, d4 = c.lane & 15;
            float o0 = 0.f, o1 = 0.f, o2 = 0.f, o3 = 0.f;
#pragma unroll 1
            for (int j0 = 0; j0 < 256; j0 += 64) {
                float4 vv[16]; float pw[16];
#pragma unroll
                for (int q = 0; q < 16; ++q) { const int j = j0 + 4 * q + ks; const int rr = j < nsel ? prow[j] : -1; const bool ok = rr >= 0;
                    pw[q] = ok ? att[h * 256 + j] : 0.f;
                    vv[q] = *(const float4*)(cv + (size_t)(ok ? rr : 0) * 128 + n * 64 + 4 * d4); }
#pragma unroll
                for (int q = 0; q < 16; ++q) { o0 += pw[q] * vv[q].x; o1 += pw[q] * vv[q].y; o2 += pw[q] * vv[q].z; o3 += pw[q] * vv[q].w; }
            }
            if (ks == 0) {
#pragma unroll
                for (int tt = 0; tt < DEC_SEQ; ++tt) { const int jn = newslot[tt]; if (jn >= 0) { const float wn = att[h * 256 + jn]; const bf16_t* vp = Vb + (size_t)(RP + b * DEC_SEQ + tt) * 128 + n * 64 + 4 * d4;
                    o0 += wn * bf2f(vp[0]); o1 += wn * bf2f(vp[1]); o2 += wn * bf2f(vp[2]); o3 += wn * bf2f(vp[3]); } }
            }
            o0 += __shfl_xor(o0, 16); o1 += __shfl_xor(o1, 16); o2 += __shfl_xor(o2, 16); o3 += __shfl_xor(o3, 16);
            o0 += __shfl_xor(o0, 32); o1 += __shfl_xor(o1, 32); o2 += __shfl_xor(o2, 32); o3 += __shfl_xor(o3, 32);
            if (ks == 0) { const unsigned e = (unsigned)row * 512u + h * 64 + 4 * d4;
                YB[e] = (bf16_t)f2bf(o0 * LD(BG, e)); YB[e + 1] = (bf16_t)f2bf(o1 * LD(BG, e + 1)); YB[e + 2] = (bf16_t)f2bf(o2 * LD(BG, e + 2)); YB[e + 3] = (bf16_t)f2bf(o3 * LD(BG, e + 3)); }
        }
    }
}
constexpr int DSA_SC_OFF = 0, DSA_SEL_OFF = 65536, DSA_P_OFF = 65536 + 4096, DSA_H_OFF = 65536;
constexpr int DSA_GPI = 4;
__device__ __forceinline__ void dsa_prompt_item(KA a, const Ctx& c, int l, int b, int tq) {
    unsigned char* ws = a->ws; (void)l;
    const bf16_t* QI = (const bf16_t*)(ws + A_QI); const bf16_t* KI = (const bf16_t*)(ws + A_KI); const float* WI = (const float*)(ws + A_WI);
    LAS unsigned* SC = (LAS unsigned*)(c.lds_las + DSA_SC_OFF);
    const int lane = c.lane, c16 = lane & 15, g = lane >> 4;
    bf16x8_t Af[2][2]; float wq[2][4]; bf16x8_t B0[8], B1[8];
#define DSA_FETCH(tb_) do { const int t0_ = 8 * (tb_), row0_ = b * SEQ + t0_, ntiles_ = (t0_ + 8 + 15) >> 4; \
        _Pragma("unroll") for (int rt = 0; rt < 2; ++rt) { \
            _Pragma("unroll") for (int ks = 0; ks < 2; ++ks) Af[rt][ks] = *(const bf16x8_t*)(QI + ((unsigned)(row0_ + 4 * rt + (c16 >> 2)) * 256u + (c16 & 3) * 64 + 32 * ks + 8 * g)); \
            const f32x4 w4 = *(const f32x4*)(WI + (unsigned)(row0_ + 4 * rt + g) * 4u); wq[rt][0] = w4[0]; wq[rt][1] = w4[1]; wq[rt][2] = w4[2]; wq[rt][3] = w4[3]; } \
        _Pragma("unroll") for (int j = 0; j < 8; ++j) { const int nt0 = c.wave + 8 * j, nt = nt0 < ntiles_ ? nt0 : ntiles_ - 1; \
            const bf16_t* kp = KI + ((unsigned)(b * SEQ + 16 * nt + c16) * 64u + 8 * g); B0[j] = *(const bf16x8_t*)kp; B1[j] = *(const bf16x8_t*)(kp + 32); } } while (0)
#define DSA_SCORE(Bx0, Bx1, nt_) do { _Pragma("unroll") for (int rt = 0; rt < 2; ++rt) { \
            f32x4 acc = (f32x4){0.f, 0.f, 0.f, 0.f}; \
            acc = __builtin_amdgcn_mfma_f32_16x16x32_bf16(Af[rt][0], Bx0, acc, 0, 0, 0); acc = __builtin_amdgcn_mfma_f32_16x16x32_bf16(Af[rt][1], Bx1, acc, 0, 0, 0); \
            float sc = fmaxf(acc[0] * 0.125f, 0.f) * wq[rt][0]; \
            sc += fmaxf(acc[1] * 0.125f, 0.f) * wq[rt][1]; sc += fmaxf(acc[2] * 0.125f, 0.f) * wq[rt][2]; sc += fmaxf(acc[3] * 0.125f, 0.f) * wq[rt][3]; \
            SC[(4 * rt + g) * 2048 + 16 * (nt_) + c16] = fkey(sc * 0.5f); } } while (0)
    const int tb_hi = DSA_GPI * tq + DSA_GPI - 1;
    if (8 * tb_hi >= TOPK) DSA_FETCH(tb_hi);
#pragma unroll 1
    for (int tb = tb_hi; tb > tb_hi - DSA_GPI; --tb) {
    const int t0 = tb * 8, row0 = b * SEQ + t0;
    __syncthreads();
    if (t0 >= TOPK) {
        const int ntiles = (t0 + 8 + 15) >> 4;
#pragma unroll
        for (int j = 0; j < 8; ++j) { const int nt = c.wave + 8 * j; if (nt < ntiles) DSA_SCORE(B0[j], B1[j], nt); }
#pragma unroll 1
        for (int base = c.wave + 64; base < ntiles; base += 64) {
#pragma unroll
            for (int j = 0; j < 8; ++j) { const int nt0 = base + 8 * j, nt = nt0 < ntiles ? nt0 : ntiles - 1;
                const bf16_t* kp = KI + ((unsigned)(b * SEQ + 16 * nt + c16) * 64u + 8 * g); B0[j] = *(const bf16x8_t*)kp; B1[j] = *(const bf16x8_t*)(kp + 32); }
#pragma unroll
            for (int j = 0; j < 8; ++j) { const int nt = base + 8 * j; if (nt < ntiles) DSA_SCORE(B0[j], B1[j], nt); }
        }
    }
    __syncthreads();
    if (tb > tb_hi - DSA_GPI + 1 && t0 - 8 >= TOPK) DSA_FETCH(tb - 1);
        const int t = t0 + c.wave, nvalid = t + 1, row = row0 + c.wave;
        unsigned* selm = (unsigned*)(ws + A_SELM) + (unsigned)row * 64u;
        if (nvalid <= TOPK) {
            if (lane < 64) { const int w0 = 32 * lane; unsigned wd = 0u; if (w0 + 31 <= t) wd = 0xffffffffu; else if (w0 <= t) wd = (t - w0 == 31) ? 0xffffffffu : ((1u << (t - w0 + 1)) - 1u); selm[lane] = wd; }
        } else {
            const int ni = __builtin_amdgcn_readfirstlane((t >> 6) + 1), niq = (ni + 3) >> 2;
            LAS unsigned* SCw = SC + c.wave * 2048 + lane;
    #pragma unroll
            for (int j = 0; j < 4; ++j) { const int i = 4 * (niq - 1) + j; if (lane + 64 * i > t) SCw[64 * i] = 0u; }
            LAS unsigned* H = (LAS unsigned*)(c.lds_las + DSA_H_OFF) + c.wave * (8 * 260);
            LAS unsigned* Hc = H + (lane >> 3) * 260;
            unsigned prefix = 0u; int need = TOPK, lastcnt = 0;
    #pragma unroll 1
            for (int pass = 0; pass < 4; ++pass) {
                const int shift = 24 - 8 * pass; const unsigned himask = pass == 0 ? 0u : (0xffffffffu << (shift + 8));
                unsigned zz = 0u; asm volatile("" : "+v"(zz));
    #pragma unroll
                for (int cp = 0; cp < 8; ++cp) *(LAS u32x4*)(H + cp * 260 + 4 * lane) = (u32x4){zz, zz, zz, zz};
                if (pass == 0) {
    #pragma unroll 1
                    for (int iq = 0; iq < niq; ++iq) {
                        const unsigned k0 = SCw[256 * iq], k1 = SCw[256 * iq + 64], k2 = SCw[256 * iq + 128], k3 = SCw[256 * iq + 192];
                        (void)__hip_atomic_fetch_add(Hc + (k0 >> 24), 1u, __ATOMIC_RELAXED, __HIP_MEMORY_SCOPE_WORKGROUP); (void)__hip_atomic_fetch_add(Hc + (k1 >> 24), 1u, __ATOMIC_RELAXED, __HIP_MEMORY_SCOPE_WORKGROUP);
                        (void)__hip_atomic_fetch_add(Hc + (k2 >> 24), 1u, __ATOMIC_RELAXED, __HIP_MEMORY_SCOPE_WORKGROUP); (void)__hip_atomic_fetch_add(Hc + (k3 >> 24), 1u, __ATOMIC_RELAXED, __HIP_MEMORY_SCOPE_WORKGROUP);
                    }
                } else {
    #pragma unroll 1
                    for (int iq = 0; iq < niq; ++iq) {
                        const unsigned k0 = SCw[256 * iq], k1 = SCw[256 * iq + 64], k2 = SCw[256 * iq + 128], k3 = SCw[256 * iq + 192];
                        const bool h0 = (k0 & himask) == prefix, h1 = (k1 & himask) == prefix, h2 = (k2 & himask) == prefix, h3 = (k3 & himask) == prefix;
                        if (__ballot(h0 || h1 || h2 || h3) == 0ull) continue;
                        if (h0) (void)__hip_atomic_fetch_add(Hc + ((k0 >> shift) & 255u), 1u, __ATOMIC_RELAXED, __HIP_MEMORY_SCOPE_WORKGROUP);
                        if (h1) (void)__hip_atomic_fetch_add(Hc + ((k1 >> shift) & 255u), 1u, __ATOMIC_RELAXED, __HIP_MEMORY_SCOPE_WORKGROUP);
                        if (h2) (void)__hip_atomic_fetch_add(Hc + ((k2 >> shift) & 255u), 1u, __ATOMIC_RELAXED, __HIP_MEMORY_SCOPE_WORKGROUP);
                        if (h3) (void)__hip_atomic_fetch_add(Hc + ((k3 >> shift) & 255u), 1u, __ATOMIC_RELAXED, __HIP_MEMORY_SCOPE_WORKGROUP);
                    }
                }
                asm volatile("s_waitcnt lgkmcnt(0)" ::: "memory"); __builtin_amdgcn_wave_barrier();
                u32x4 hh[8];
    #pragma unroll
                for (int cp = 0; cp < 8; ++cp) hh[cp] = *(const LAS u32x4*)(H + cp * 260 + 4 * lane);
                asm volatile("s_waitcnt lgkmcnt(0)" ::: "memory");
                const u32x4 cnt = ((hh[0] + hh[1]) + (hh[2] + hh[3])) + ((hh[4] + hh[5]) + (hh[6] + hh[7]));
                const int ssum = (int)(cnt.x + cnt.y + cnt.z + cnt.w);
                int pre = ssum;
                pre += __builtin_amdgcn_update_dpp(0, pre, 0x111, 0xf, 0xf, false);
                pre += __builtin_amdgcn_update_dpp(0, pre, 0x112, 0xf, 0xf, false);
                pre += __builtin_amdgcn_update_dpp(0, pre, 0x114, 0xf, 0xf, false);
                pre += __builtin_amdgcn_update_dpp(0, pre, 0x118, 0xf, 0xf, false);
                pre += __builtin_amdgcn_update_dpp(0, pre, 0x142, 0xa, 0xf, false);
                pre += __builtin_amdgcn_update_dpp(0, pre, 0x143, 0xc, 0xf, false);
                const int total = __builtin_amdgcn_readlane(pre, 63);
                const int suf = total - pre + ssum;
                const unsigned long long m = __ballot(suf >= need);
                const int L = 63 - __clzll(m);
                const int above = L < 63 ? __builtin_amdgcn_readlane(suf, (L + 1) & 63) : 0;
                const int cx = __builtin_amdgcn_readlane((int)cnt.x, L), cy = __builtin_amdgcn_readlane((int)cnt.y, L), cz = __builtin_amdgcn_readlane((int)cnt.z, L), cw = __builtin_amdgcn_readlane((int)cnt.w, L);
                int q, ab;
                if (above + cw >= need) { q = 3; ab = above; lastcnt = cw; } else if (above + cw + cz >= need) { q = 2; ab = above + cw; lastcnt = cz; }
                else if (above + cw + cz + cy >= need) { q = 1; ab = above + cw + cz; lastcnt = cy; } else { q = 0; ab = above + cw + cz + cy; lastcnt = cx; }
                prefix |= (unsigned)(4 * L + q) << shift; need -= ab;
                if (need == lastcnt) break;
            }
            unsigned mylo = 0u, myhi = 0u;
            if (need == lastcnt && prefix != 0u) {
    #pragma unroll 1
                for (int iq = 0; iq < niq; ++iq) {
                    const unsigned k0 = SCw[256 * iq], k1 = SCw[256 * iq + 64], k2 = SCw[256 * iq + 128], k3 = SCw[256 * iq + 192];
                    const unsigned long long m0 = __ballot(k0 >= prefix), m1 = __ballot(k1 >= prefix), m2 = __ballot(k2 >= prefix), m3 = __ballot(k3 >= prefix);
                    const int i0 = 4 * iq;
                    if (lane == i0) { mylo = (unsigned)m0; myhi = (unsigned)(m0 >> 32); }
                    if (lane == i0 + 1) { mylo = (unsigned)m1; myhi = (unsigned)(m1 >> 32); }
                    if (lane == i0 + 2) { mylo = (unsigned)m2; myhi = (unsigned)(m2 >> 32); }
                    if (lane == i0 + 3) { mylo = (unsigned)m3; myhi = (unsigned)(m3 >> 32); }
                }
            } else {
                int ties_before = 0;
                const unsigned long long lt = (1ull << lane) - 1ull;
    #pragma unroll 1
                for (int i = 0; i < 4 * niq; ++i) {
                    const unsigned kk = SCw[64 * i];
                    const bool gt = kk > prefix, tie = kk == prefix;
                    const unsigned long long mt = __ballot(tie);
                    const bool take = gt || (tie && (ties_before + __popcll(mt & lt) < need));
                    const unsigned long long ms = __ballot(take);
                    if (lane == i) { mylo = (unsigned)ms; myhi = (unsigned)(ms >> 32); }
                    ties_before += __popcll(mt);
                }
            }
            if (lane < 32) *(u32x2*)(selm + 2 * lane) = (u32x2){mylo, myhi};
        }
    }
#undef DSA_FETCH
#undef DSA_SCORE
}
constexpr int HG_AQ = 0, HG_KT = HG_AQ + 32 * 272, HG_KHT = HG_KT + 32 * 272, HG_IT = HG_KHT + 128 * 80, HG_ATT = HG_IT + 128 * 80, HG_TOT = HG_ATT + 32 * 80, HG_EB = HG_TOT + 2048, HG_PART = HG_EB + 512;
__device__ __forceinline__ bf16x8_t ld_perm_frag(const LAS bf16_t* rowp, int ks, int g) {
    const u32x2 lo = *(const LAS u32x2*)(rowp + 32 * ks + 4 * g), hi = *(const LAS u32x2*)(rowp + 32 * ks + 16 + 4 * g);
    const u32x4 w = (u32x4){lo.x, lo.y, hi.x, hi.y}; return __builtin_bit_cast(bf16x8_t, w);
}
#define HG_STORE_CHUNK(nn) do { _Pragma("unroll") for (int tt = 0; tt < 2; ++tt) _Pragma("unroll") for (int r = 0; r < 4; ++r) { const int t = 16 * tt + 4 * g + r; const float tot = PART[((nn) & 1) * 32 + t]; \
        const unsigned e = (row0 + 32u * (nn) + t) * 512u + hc + 16 * w + c16; \
        YC[e] = (bf16_t)f2bf(o[tt][r] * rsqrtf(tot * (1.f / 128.f) + EPS) * cgv * bf2f((bf16_t)cgl[4 * tt + r])); } } while (0)
template <int TT, int ST>
__device__ __forceinline__ void hgrn_att_tile(const bf16x8_t (&A)[4], const LAS bf16_t* Kt, LAS bf16_t* ATT, int c16, int g) {
    f32x4 acc = (f32x4){0.f, 0.f, 0.f, 0.f};
#pragma unroll
    for (int ks = 0; ks < 4; ++ks) { const bf16x8_t Bk = ld_perm_frag(Kt + (16 * ST + c16) * 136, ks, g); acc = __builtin_amdgcn_mfma_f32_16x16x32_bf16(A[ks], Bk, acc, 0, 0, 0); }
#pragma unroll
    for (int r = 0; r < 4; ++r) { const float v = (TT != ST || c16 <= 4 * g + r) ? acc[r] : 0.f; ATT[(16 * TT + 4 * g + r) * 40 + 16 * ST + c16] = (bf16_t)f2bf(v); }
}
__device__ __forceinline__ void hgrn_prompt_item(KA a, const Ctx& c, int l, int b, int h, int n0, int n1) {
    unsigned char* ws = a->ws;
    const bf16_t* CQ = (const bf16_t*)(ws + A_CQ); const float* LF = (const float*)(ws + A_LF); const bf16_t* KK = (const bf16_t*)(ws + A_KK);
    const bf16_t* CI = (const bf16_t*)(ws + A_CI); const bf16_t* CG = (const bf16_t*)(ws + A_CG); bf16_t* YC = (bf16_t*)(ws + A_YC);
    const float* cg = a->c_norm_g + l * C_VDIM;
    LAS bf16_t* Aq = (LAS bf16_t*)(c.lds_las + HG_AQ); LAS bf16_t* Kt = (LAS bf16_t*)(c.lds_las + HG_KT); LAS bf16_t* KhT = (LAS bf16_t*)(c.lds_las + HG_KHT);
    LAS bf16_t* IT = (LAS bf16_t*)(c.lds_las + HG_IT); LAS bf16_t* ATT = (LAS bf16_t*)(c.lds_las + HG_ATT); LAS float* TOT = (LAS float*)(c.lds_las + HG_TOT);
    LAS float* EB = (LAS float*)(c.lds_las + HG_EB); LAS float* PART = (LAS float*)(c.lds_las + HG_PART);
    const int tid = c.tid, lane = c.lane, w = c.wave, c16 = lane & 15, g = lane >> 4, d = tid & 127, tq = tid >> 7;
    const unsigned hc = (unsigned)h * 128u, row0 = (unsigned)b * SEQ;
    f32x4 S[8];
    float* so = a->out + O_HGP + (((size_t)l * BATCH + b) * C_HEADS + h) * C_KDIM * C_VDIM;
#pragma unroll
    for (int dt = 0; dt < 8; ++dt) {
        S[dt] = (f32x4){0.f, 0.f, 0.f, 0.f};
        if (n0 > 0) {
#pragma unroll
            for (int r = 0; r < 4; ++r) S[dt][r] = so[(16 * dt + 4 * g + r) * C_VDIM + 16 * w + c16];
        } }
    const float cgv = cg[16 * w + c16];
    f32x4 o[2] = {(f32x4){0.f, 0.f, 0.f, 0.f}, (f32x4){0.f, 0.f, 0.f, 0.f}};
    float nlf[8]; unsigned nq[8], nk[8], ni[8]; unsigned cgl[8];
#pragma unroll
    for (int i = 0; i < 8; ++i) { const unsigned e = (row0 + 32u * n0 + 8u * tq + i) * 512u + hc + d; nlf[i] = LF[e]; nq[i] = CQ[e]; nk[i] = KK[e]; ni[i] = CI[e]; }
    __syncthreads();
#pragma unroll 1
    for (int n = n0; n < n1; ++n) {
        float lf[8], qv[8], kv[8]; unsigned iv[8];
#pragma unroll
        for (int i = 0; i < 8; ++i) { lf[i] = nlf[i]; qv[i] = bf2f((bf16_t)nq[i]); kv[i] = bf2f((bf16_t)nk[i]); iv[i] = ni[i]; }
        float run = 0.f;
#pragma unroll
        for (int i = 0; i < 8; ++i) { run += lf[i]; lf[i] = run; }
        TOT[tq * 128 + d] = run;
        asm volatile("s_waitcnt lgkmcnt(0)" ::: "memory"); __syncthreads();
        if (n > n0) HG_STORE_CHUNK(n - 1);
        const float t0 = TOT[d], t1 = TOT[128 + d], t2 = TOT[256 + d], t3 = TOT[384 + d];
        const float off = (tq > 0 ? t0 : 0.f) + (tq > 1 ? t1 : 0.f) + (tq > 2 ? t2 : 0.f), bend = (t0 + t1) + (t2 + t3);
        unsigned khp[4], itp[4]; const float ebend = __expf(bend);
#pragma unroll
        for (int i = 0; i < 8; i += 2) {
            const float b0 = off + lf[i], b1 = off + lf[i + 1];
            const float a0 = qv[i] * __expf(b0), a1 = qv[i + 1] * __expf(b1);
            const float k0 = kv[i] * __expf(fminf(-b0, 80.f)), k1 = kv[i + 1] * __expf(fminf(-b1, 80.f));
            Aq[(8 * tq + i) * 136 + d] = (bf16_t)f2bf(a0); Aq[(8 * tq + i + 1) * 136 + d] = (bf16_t)f2bf(a1);
            Kt[(8 * tq + i) * 136 + d] = (bf16_t)f2bf(k0); Kt[(8 * tq + i + 1) * 136 + d] = (bf16_t)f2bf(k1);
            khp[i >> 1] = pk2(k0 * ebend, k1 * ebend);
            itp[i >> 1] = iv[i] | (iv[i + 1] << 16);
        }
        *(LAS u32x4*)(KhT + d * 40 + 8 * tq) = (u32x4){khp[0], khp[1], khp[2], khp[3]};
        *(LAS u32x4*)(IT + d * 40 + 8 * tq) = (u32x4){itp[0], itp[1], itp[2], itp[3]};
        if (tq == 0) EB[d] = ebend;
        if (tid < 32) PART[(n & 1) * 32 + tid] = 0.f;
#pragma unroll
        for (int tt = 0; tt < 2; ++tt)
#pragma unroll
            for (int r = 0; r < 4; ++r) cgl[4 * tt + r] = CG[(row0 + 32u * n + 16 * tt + 4 * g + r) * 512u + hc + 16 * w + c16];
        if (n + 1 < n1) {
#pragma unroll
            for (int i = 0; i < 8; ++i) { const unsigned e = (row0 + 32u * (n + 1) + 8u * tq + i) * 512u + hc + d; nlf[i] = LF[e]; nq[i] = CQ[e]; nk[i] = KK[e]; ni[i] = CI[e]; }
        }
        asm volatile("s_waitcnt lgkmcnt(0)" ::: "memory"); __syncthreads();
        bf16x8_t Af[2][4];
#pragma unroll
        for (int tt = 0; tt < 2; ++tt)
#pragma unroll
            for (int ks = 0; ks < 4; ++ks) Af[tt][ks] = ld_perm_frag(Aq + (16 * tt + c16) * 136, ks, g);
        if (w == 0) hgrn_att_tile<0, 0>(Af[0], Kt, ATT, c16, g);
        else if (w == 1) hgrn_att_tile<1, 0>(Af[1], Kt, ATT, c16, g);
        else if (w == 2) hgrn_att_tile<1, 1>(Af[1], Kt, ATT, c16, g);
        else if (w == 3) {
#pragma unroll
            for (int r = 0; r < 4; ++r) ATT[(4 * g + r) * 40 + 16 + c16] = (bf16_t)0;
        }
        o[0] = (f32x4){0.f, 0.f, 0.f, 0.f}; o[1] = (f32x4){0.f, 0.f, 0.f, 0.f};
#pragma unroll
        for (int ks = 0; ks < 4; ++ks) {
            const u32x4 bw = (u32x4){pk2(S[2 * ks][0], S[2 * ks][1]), pk2(S[2 * ks][2], S[2 * ks][3]), pk2(S[2 * ks + 1][0], S[2 * ks + 1][1]), pk2(S[2 * ks + 1][2], S[2 * ks + 1][3])};
            const bf16x8_t Bs = __builtin_bit_cast(bf16x8_t, bw);
            o[0] = __builtin_amdgcn_mfma_f32_16x16x32_bf16(Af[0][ks], Bs, o[0], 0, 0, 0);
            o[1] = __builtin_amdgcn_mfma_f32_16x16x32_bf16(Af[1][ks], Bs, o[1], 0, 0, 0);
        }
        const bf16x8_t Bi = *(const LAS bf16x8_t*)(IT + (16 * w + c16) * 40 + 8 * g);
#pragma unroll
        for (int dt = 0; dt < 8; ++dt) { const bf16x8_t Ak = *(const LAS bf16x8_t*)(KhT + (16 * dt + c16) * 40 + 8 * g); const f32x4 eb4 = *(const LAS f32x4*)(EB + 16 * dt + 4 * g);
            S[dt] = __builtin_amdgcn_mfma_f32_16x16x32_bf16(Ak, Bi, S[dt] * eb4, 0, 0, 0); }
        asm volatile("s_waitcnt lgkmcnt(0)" ::: "memory"); __syncthreads();
#pragma unroll
        for (int tt = 0; tt < 2; ++tt) { const bf16x8_t Aa = *(const LAS bf16x8_t*)(ATT + (16 * tt + c16) * 40 + 8 * g); o[tt] = __builtin_amdgcn_mfma_f32_16x16x32_bf16(Aa, Bi, o[tt], 0, 0, 0); }
#pragma unroll
        for (int tt = 0; tt < 2; ++tt)
#pragma unroll
            for (int r = 0; r < 4; ++r) { float ss = o[tt][r] * o[tt][r];
                ss += __builtin_bit_cast(float, __builtin_amdgcn_update_dpp(0, __builtin_bit_cast(int, ss), 0x111, 0xf, 0xf, false));
                ss += __builtin_bit_cast(float, __builtin_amdgcn_update_dpp(0, __builtin_bit_cast(int, ss), 0x112, 0xf, 0xf, false));
                ss += __builtin_bit_cast(float, __builtin_amdgcn_update_dpp(0, __builtin_bit_cast(int, ss), 0x114, 0xf, 0xf, false));
                ss += __builtin_bit_cast(float, __builtin_amdgcn_update_dpp(0, __builtin_bit_cast(int, ss), 0x118, 0xf, 0xf, false));
                if (c16 == 15) atomicAdd((float*)(PART + (n & 1) * 32 + 16 * tt + 4 * g + r), ss); }
    }
    asm volatile("s_waitcnt lgkmcnt(0)" ::: "memory"); __syncthreads();
    HG_STORE_CHUNK(n1 - 1);
#pragma unroll
    for (int dt = 0; dt < 8; ++dt)
#pragma unroll
        for (int r = 0; r < 4; ++r) so[(16 * dt + 4 * g + r) * C_VDIM + 16 * w + c16] = S[dt][r];
}
__device__ __forceinline__ void mix_hgrn_prompt(KA a, const Ctx& c, int l) {
    for (int it = c.bid; it < BATCH * C_HEADS; it += c.nblk) { hgrn_prompt_item(a, c, l, it / C_HEADS, it % C_HEADS, 0, 64); }
}
__device__ __forceinline__ bool hgrn_is_early(KA a, const Ctx& c) { return c.nblk == 256 && a->use_bar != 0; }
__device__ __forceinline__ void hgrn_early(KA a, const Ctx& c, int l) {
    if (!hgrn_is_early(a, c) || c.bid < 224) return;
    unsigned* ctr = (unsigned*)(a->ws + WS_CTL) + CW_HGE + 64 * l;
    __syncthreads();
    if (c.tid == 0) { unsigned sp = 0u; while (__hip_atomic_load(ctr, __ATOMIC_RELAXED, __HIP_MEMORY_SCOPE_AGENT) < 256u) { __builtin_amdgcn_s_sleep(2); if (++sp > (1u << 22)) break; }
        __builtin_amdgcn_fence(__ATOMIC_ACQUIRE, "agent"); asm volatile("s_waitcnt vmcnt(0)" ::: "memory"); }
    __syncthreads();
    hgrn_prompt_item(a, c, l, (c.bid - 224) >> 2, (c.bid - 224) & 3, 0, HG_EARLY);
}

template <bool SAMPLE>
__device__ __forceinline__ void conv_item(KA a, const Ctx& c, int l, int b, int tt) {
    unsigned char* ws = a->ws;
    const bf16_t* U = (const bf16_t*)(ws + A_U); const bf16_t* AG = (const bf16_t*)(ws + A_AG); bf16_t* YA = (bf16_t*)(ws + A_YA);
    const float* wdw = a->w_dw + (size_t)l * CONV_W * D_A;
    LAS float* Y = (LAS float*)c.lds_las;
    constexpr int NTOK = SAMPLE ? DEC_SEQ : 32, NWIN = NTOK + 30;
    const int ch = c.tid; const int t0 = SAMPLE ? 0 : 32 * tt; const unsigned rowb = SAMPLE ? (unsigned)(RP + b * DEC_SEQ) : (unsigned)(b * SEQ + t0);
    constexpr int NTW = (NTOK + 7) / 8;
    u32x4 agr[NTW]; float g8[8], b8[8];
    { const float* lg = a->ln_g + l * D_A + 8 * c.lane; const float* lb = a->ln_b + l * D_A + 8 * c.lane; ld8(lg, g8); ld8(lb, b8); }
#pragma unroll
    for (int i = 0; i < NTW; ++i) { const int t = c.wave + 8 * i, tc = t < NTOK ? t : NTOK - 1; agr[i] = *(const u32x4*)(AG + (rowb + tc) * 512u + 8 * c.lane); }
    __syncthreads();
    {
        float win[NWIN];
        if (SAMPLE) {
            const float* buf = a->state_conv + ((size_t)l * DEC_BATCH + b) * 30 * D_A;
#pragma unroll
            for (int i = 0; i < 30; ++i) win[i] = buf[i * D_A + ch];
#pragma unroll
            for (int i = 0; i < DEC_SEQ; ++i) win[30 + i] = bf2f(U[(rowb + i) * 512u + ch]);
            float* so = a->out + O_CVS + ((size_t)l * DEC_BATCH + b) * 30 * D_A;
#pragma unroll
            for (int j = 0; j < 26; ++j) so[j * D_A + ch] = win[j + DEC_SEQ];
        } else {
#pragma unroll
            for (int i = 0; i < NWIN; ++i) { const int t = t0 - 30 + i; const int tc = t >= 0 ? t : 0;
                const float uv = bf2f(U[(unsigned)(b * SEQ + tc) * 512u + ch]); win[i] = t >= 0 ? uv : 0.f; }
        }
        float y[NTOK]; const float bias = a->b_dw[l * D_A + ch];
#pragma unroll
        for (int t = 0; t < NTOK; ++t) y[t] = bias;
        float wj[CONV_W];
#pragma unroll
        for (int j = 0; j < CONV_W; ++j) wj[j] = wdw[j * D_A + ch];
#pragma unroll
        for (int j = 0; j < CONV_W; ++j) {
#pragma unroll
            for (int t = 0; t < NTOK; ++t) y[t] += wj[j] * win[t + j]; }
#pragma unroll
        for (int t = 0; t < NTOK; ++t) Y[t * 512 + ch] = y[t];
    }
    asm volatile("s_waitcnt lgkmcnt(0)" ::: "memory"); __syncthreads();
    {
        const int lane = c.lane;
#pragma unroll
        for (int i = 0; i < NTW; ++i) { const int t = c.wave + 8 * i; if (t < NTOK) {
            float v[8]; { const f32x4 v0 = *(const LAS f32x4*)(Y + t * 512 + 8 * lane), v1 = *(const LAS f32x4*)(Y + t * 512 + 8 * lane + 4); v[0] = v0[0]; v[1] = v0[1]; v[2] = v0[2]; v[3] = v0[3]; v[4] = v1[0]; v[5] = v1[1]; v[6] = v1[2]; v[7] = v1[3]; }
            float s = 0.f;
#pragma unroll
            for (int e = 0; e < 8; ++e) s += v[e];
            const float mu = wave_sum(s) * (1.f / D_A); float q = 0.f;
#pragma unroll
            for (int e = 0; e < 8; ++e) { v[e] -= mu; q += v[e] * v[e]; }
            const float rstd = rsqrtf(wave_sum(q) * (1.f / D_A) + EPS);
            const unsigned o = (rowb + t) * 512u + 8 * lane; float ag[8]; { const u32x4 w_ = agr[i]; ag[0] = __uint_as_float(w_.x << 16); ag[1] = __uint_as_float(w_.x & 0xffff0000u); ag[2] = __uint_as_float(w_.y << 16); ag[3] = __uint_as_float(w_.y & 0xffff0000u); ag[4] = __uint_as_float(w_.z << 16); ag[5] = __uint_as_float(w_.z & 0xffff0000u); ag[6] = __uint_as_float(w_.w << 16); ag[7] = __uint_as_float(w_.w & 0xffff0000u); }
            float r[8];
#pragma unroll
            for (int e = 0; e < 8; ++e) { const float ln = v[e] * rstd * g8[e] + b8[e]; r[e] = ln * fsig(ln) * ag[e]; }
            u32x4 w; w.x = pk2(r[0], r[1]); w.y = pk2(r[2], r[3]); w.z = pk2(r[4], r[5]); w.w = pk2(r[6], r[7]);
            *(u32x4*)(YA + o) = w;
        } }
    }
}

constexpr int DA_KT = 0, DA_VT = DA_KT + 2 * 9216, DA_TILE = 9216;
__device__ __forceinline__ void da_compute(const LAS bf16_t* KT, const LAS bf16_t* VTl, const unsigned (&mw)[2][2], const bf16x8_t (&Bq)[2][2], f32x4 (&O)[2][4], float (&lsum)[2], int c16, int g) {
#pragma unroll
    for (int sub = 0; sub < 2; ++sub) {
        f32x4 sc[2][2];
#pragma unroll
        for (int nt = 0; nt < 2; ++nt) {
            const LAS bf16_t* kp = KT + (32 * sub + 16 * nt + c16) * 72 + 8 * g;
            const bf16x8_t A0 = *(const LAS bf16x8_t*)kp, A1 = *(const LAS bf16x8_t*)(kp + 32);
            __builtin_amdgcn_s_setprio(1);
#pragma unroll
            for (int j = 0; j < 2; ++j) {
                f32x4 acc = (f32x4){0.f, 0.f, 0.f, 0.f};
                acc = __builtin_amdgcn_mfma_f32_16x16x32_bf16(A0, Bq[j][0], acc, 0, 0, 0);
                sc[j][nt] = __builtin_amdgcn_mfma_f32_16x16x32_bf16(A1, Bq[j][1], acc, 0, 0, 0);
            }
            __builtin_amdgcn_s_setprio(0);
        }
        bf16x8_t Bp[2];
#pragma unroll
        for (int j = 0; j < 2; ++j) {
            const unsigned bits = mw[j][sub] >> (4 * g);
            float p[8];
#pragma unroll
            for (int nt = 0; nt < 2; ++nt)
#pragma unroll
                for (int r = 0; r < 4; ++r) { const float e = __builtin_amdgcn_exp2f(sc[j][nt][r] * (0.125f * 1.4426950408889634f)); p[4 * nt + r] = ((bits >> (16 * nt + r)) & 1u) ? e : 0.f; }
            lsum[j] += ((p[0] + p[1]) + (p[2] + p[3])) + ((p[4] + p[5]) + (p[6] + p[7]));
            const u32x4 pw = (u32x4){pg8::cvt_pk_bf16(p[0], p[1]), pg8::cvt_pk_bf16(p[2], p[3]), pg8::cvt_pk_bf16(p[4], p[5]), pg8::cvt_pk_bf16(p[6], p[7])};
            Bp[j] = __builtin_bit_cast(bf16x8_t, pw);
        }
#pragma unroll
        for (int dt = 0; dt < 4; ++dt) {
            const LAS bf16_t* vp = VTl + (16 * dt + c16) * 72 + 32 * sub + 4 * g;
            const u32x2 lo = *(const LAS u32x2*)vp, hi = *(const LAS u32x2*)(vp + 16);
            const u32x4 vw = (u32x4){lo.x, lo.y, hi.x, hi.y}; const bf16x8_t Av = __builtin_bit_cast(bf16x8_t, vw);
            __builtin_amdgcn_s_setprio(1);
            O[0][dt] = __builtin_amdgcn_mfma_f32_16x16x32_bf16(Av, Bp[0], O[0][dt], 0, 0, 0);
            O[1][dt] = __builtin_amdgcn_mfma_f32_16x16x32_bf16(Av, Bp[1], O[1][dt], 0, 0, 0);
            __builtin_amdgcn_s_setprio(0);
        }
    }
}
__device__ __forceinline__ void dense_attn_item(KA a, const Ctx& c, int l, int b, int n, int q2) {
    unsigned char* ws = a->ws; (void)l;
    const bf16_t* Q = (const bf16_t*)(ws + A_Q); const bf16_t* Kb = (const bf16_t*)(ws + A_K); const bf16_t* VT = (const bf16_t*)(ws + A_VT);
    const unsigned* selm = (const unsigned*)(ws + A_SELM); const bf16_t* BG = (const bf16_t*)(ws + A_BG); bf16_t* YB = (bf16_t*)(ws + A_YB);
    const int tid = c.tid, lane = c.lane, w = c.wave, c16 = lane & 15, g = lane >> 4, t0 = 64 * q2;
    const unsigned qrow0 = (unsigned)(b * SEQ + t0 + 8 * w + (c16 >> 2));
    bf16x8_t Bq[2][2];
#pragma unroll
    for (int j = 0; j < 2; ++j)
#pragma unroll
        for (int ks = 0; ks < 2; ++ks) Bq[j][ks] = *(const bf16x8_t*)(Q + ((qrow0 + 4 * j) * 512u + (4 * n + (c16 & 3)) * 64 + 32 * ks + 8 * g));
    const unsigned* mrow0 = selm + qrow0 * 64u; const unsigned* mrow1 = mrow0 + 4 * 64;
    const int trow = tid >> 3, tch = tid & 7;
    const bf16_t* kg = Kb + ((unsigned)(b * SEQ + trow) * 128u + n * 64 + 8 * tch);
    const bf16_t* vg = VT + ((unsigned)((b * 2 + n) * 64 + trow) * (unsigned)SEQ + 8 * tch);
    const int lds_off = trow * 72 + 8 * tch;
    f32x4 O[2][4];
#pragma unroll
    for (int j = 0; j < 2; ++j)
#pragma unroll
        for (int dt = 0; dt < 4; ++dt) O[j][dt] = (f32x4){0.f, 0.f, 0.f, 0.f};
    float lsum[2] = {0.f, 0.f};
    const int M = q2 + 1;
    LAS bf16_t* KT0 = (LAS bf16_t*)(c.lds_las + DA_KT); LAS bf16_t* KT1 = (LAS bf16_t*)(c.lds_las + DA_KT + DA_TILE);
    LAS bf16_t* VT0 = (LAS bf16_t*)(c.lds_las + DA_VT); LAS bf16_t* VT1 = (LAS bf16_t*)(c.lds_las + DA_VT + DA_TILE);
    const int Mp = (M + 1) & ~1;
#define DA_TILE_LD(rk_, rv_, m_) do { const int mc_ = (m_) < M ? (m_) : M - 1; rk_ = *(const u32x4*)(kg + (unsigned)(64 * mc_) * 128u); rv_ = *(const u32x4*)(vg + 64 * mc_); } while (0)
#define DA_MW_LD(dst_, m_) do { const int s0_ = 2 * (m_) < 64 ? 2 * (m_) : 62; const u32x2 x0_ = *(const u32x2*)(mrow0 + s0_), x1_ = *(const u32x2*)(mrow1 + s0_); \
        dst_[0][0] = x0_.x; dst_[0][1] = x0_.y; dst_[1][0] = x1_.x; dst_[1][1] = x1_.y; } while (0)
    u32x4 rkA, rvA, rkB, rvB;
    { u32x4 rk0, rv0; DA_TILE_LD(rk0, rv0, 0); *(LAS u32x4*)(KT0 + lds_off) = rk0; *(LAS u32x4*)(VT0 + lds_off) = rv0; }
    DA_TILE_LD(rkA, rvA, 1); DA_TILE_LD(rkB, rvB, 2);
    unsigned mw0[2][2], mw1[2][2];
    DA_MW_LD(mw0, 0); DA_MW_LD(mw1, 1);
    asm volatile("s_waitcnt lgkmcnt(0)" ::: "memory"); __syncthreads();
#pragma unroll 1
    for (int m = 0; m < Mp; m += 2) {
        unsigned nw0[2][2], nw1[2][2];
        DA_MW_LD(nw0, m + 2);
        da_compute(KT0, VT0, mw0, Bq, O, lsum, c16, g);
        *(LAS u32x4*)(KT1 + lds_off) = rkA; *(LAS u32x4*)(VT1 + lds_off) = rvA;
        DA_TILE_LD(rkA, rvA, m + 3);
        asm volatile("s_waitcnt lgkmcnt(0)" ::: "memory"); __syncthreads();
        DA_MW_LD(nw1, m + 3);
        da_compute(KT1, VT1, mw1, Bq, O, lsum, c16, g);
        *(LAS u32x4*)(KT0 + lds_off) = rkB; *(LAS u32x4*)(VT0 + lds_off) = rvB;
        DA_TILE_LD(rkB, rvB, m + 4);
        asm volatile("s_waitcnt lgkmcnt(0)" ::: "memory"); __syncthreads();
#pragma unroll
        for (int j = 0; j < 2; ++j) { mw0[j][0] = nw0[j][0]; mw0[j][1] = nw0[j][1]; mw1[j][0] = nw1[j][0]; mw1[j][1] = nw1[j][1]; }
    }
#undef DA_TILE_LD
#undef DA_MW_LD
#pragma unroll
    for (int j = 0; j < 2; ++j) {
        float ls = lsum[j]; ls += __shfl_xor(ls, 16); ls += __shfl_xor(ls, 32);
        const float inv = 1.f / ls;
#pragma unroll
        for (int dt = 0; dt < 4; ++dt) {
            const unsigned e = (qrow0 + 4 * j) * 512u + (4 * n + (c16 & 3)) * 64 + 16 * dt + 4 * g;
            const u32x2 gw = *(const u32x2*)(BG + e);
            const float g0 = __uint_as_float(gw.x << 16), g1 = __uint_as_float(gw.x & 0xffff0000u), g2 = __uint_as_float(gw.y << 16), g3 = __uint_as_float(gw.y & 0xffff0000u);
            *(u32x2*)(YB + e) = (u32x2){pk2(O[j][dt][0] * inv * g0, O[j][dt][1] * inv * g1), pk2(O[j][dt][2] * inv * g2, O[j][dt][3] * inv * g3)};
        }
    }
}
constexpr int CW_QUEUE = 8192;
constexpr int Q_SDSA = DEC_BATCH * DEC_SEQ  , Q_PDSA = BATCH * 256  , Q_CONV = BATCH * (SEQ / 32)  , Q_SCONV = DEC_BATCH, Q_SHGRN = DEC_BATCH * C_HEADS;
constexpr int Q_TOTAL = Q_SDSA + Q_PDSA + Q_CONV + Q_SCONV + Q_SHGRN;
constexpr int QX_TOTAL = 4 + 16 / DSA_TPI + 256 / DSA_GPI + 64 + 4 + 16;
__device__ __forceinline__ int q_next(unsigned* ctr, const Ctx& c) {
    LAS int* slot = (LAS int*)(c.lds_las + (LDS_BYTES - 128));
    __syncthreads();
    if (c.tid == 0) *slot = (int)__hip_atomic_fetch_add(ctr, 1u, __ATOMIC_RELAXED, __HIP_MEMORY_SCOPE_AGENT);
    __syncthreads();
    return *slot;
}

__device__ __forceinline__ unsigned q_live(unsigned* ctr0, unsigned limit, const Ctx& c) {
    LAS unsigned* slot = (LAS unsigned*)(c.lds_las + (LDS_BYTES - 128 + 16));
    __syncthreads();
    if (c.tid < 64) { unsigned v = limit; if (c.tid < 8) v = __hip_atomic_load(ctr0 + 64 * c.tid, __ATOMIC_RELAXED, __HIP_MEMORY_SCOPE_AGENT);
        const unsigned long long m = __ballot(v < limit); if (c.tid == 0) *slot = (unsigned)m; }
    __syncthreads();
    return (unsigned)__builtin_amdgcn_readfirstlane((int)*slot);
}
__device__ __forceinline__ void mix_all(KA a, const Ctx& c0, int l0) {
    Ctx c = c0; int l = l0;
    const int xcc = (int)(xb_xcc_id() & 7u);
    unsigned live = 0xffu;
#pragma unroll 1
    for (int qi = 0; qi < 8; ++qi) {
        const int bq = (xcc + qi) & 7;
        if (qi > 0) { if (qi == 1 || ((live >> bq) & 1u)) live = q_live((unsigned*)(a->ws + WS_CTL) + CW_QUEUE + 64 * (l * 8), QX_TOTAL, c); if (live == 0u) break; if (!((live >> bq) & 1u)) continue; }
        for (;;) {
            asm volatile("" : "+v"(c.tid), "+v"(c.lane));
            unsigned* ctr = (unsigned*)(a->ws + WS_CTL) + CW_QUEUE + 64 * (l * 8 + bq);
            int it = q_next(ctr, c);
            if (it >= QX_TOTAL) break;
            if (it < 4) { hgrn_prompt_item(a, c, l, bq, it, hgrn_is_early(a, c) ? HG_EARLY : 0, 64); continue; } it -= 4;
            if (it < 16 / DSA_TPI) { mix_dsa4(a, c, l, 4 * bq + it / (DEC_SEQ / DSA_TPI), it % (DEC_SEQ / DSA_TPI)); continue; } it -= 16 / DSA_TPI;
            if (it < 32) { dsa_prompt_item(a, c, l, bq, 256 / DSA_GPI - 1 - it); continue; } it -= 32;
            if (it < 64) { conv_item<false>(a, c, l, bq, it); continue; } it -= 64;
            if (it < 4) { conv_item<true>(a, c, l, 4 * bq + it, 0); continue; } it -= 4;
            if (it < 16) { const int item = BATCH * C_HEADS + 16 * bq + it; mix_hgrn(a, c, l, item, item + 1); continue; } it -= 16;
            dsa_prompt_item(a, c, l, bq, 256 / DSA_GPI - 1 - 32 - it);
        }
    }
}

__device__ __forceinline__ void sample_proj_slab(KA a, const Ctx& c, int l, int ct);
__device__ __forceinline__ void phase_attn(KA a, const Ctx& c0, int l) {
    Ctx c = c0;
    const int xcc = (int)(xb_xcc_id() & 7u);
    unsigned live = 0xffu;
#pragma unroll 1
    for (int qi = 0; qi < 8; ++qi) {
        const int bq = (xcc + qi) & 7;
        if (qi > 0) { if (qi == 1 || ((live >> bq) & 1u)) live = q_live((unsigned*)(a->ws + WS_CTL) + CW_QUEUE + 64 * (16 + l * 8), 72u, c); if (live == 0u) break; if (!((live >> bq) & 1u)) continue; }
        for (;;) {
            asm volatile("" : "+v"(c.tid), "+v"(c.lane));
            unsigned* ctr = (unsigned*)(a->ws + WS_CTL) + CW_QUEUE + 64 * (16 + l * 8 + bq);
            int it = q_next(ctr, c);
            if (it >= 72) break;
            if (it >= 64) { sample_proj_slab(a, c, l, 8 * bq + (it - 64)); continue; }
            dense_attn_item(a, c, l, bq, it & 1, 31 - (it >> 1));
        }
    }
}

template <int K>
__device__ __forceinline__ f32x4 sample_dot(const bf16_t* Arow, const bf16_t* Brow, int g) {
    f32x4 acc = (f32x4){0.f, 0.f, 0.f, 0.f};
#pragma unroll 8
    for (int ks = 0; ks < K / 32; ++ks) {
        const bf16x8_t A = *(const bf16x8_t*)(Arow + 32 * ks + 8 * g), B = *(const bf16x8_t*)(Brow + 32 * ks + 8 * g);
        acc = __builtin_amdgcn_mfma_f32_16x16x32_bf16(A, B, acc, 0, 0, 0);
    }
    return acc;
}
__device__ __forceinline__ void sample_proj_slab(KA a, const Ctx& c, int l, int ct) {
    unsigned char* ws = a->ws; const int c16 = c.lane & 15, g = c.lane >> 4, w = c.wave;
    {
        const unsigned arow = (unsigned)(RP + 16 * w + c16), bcol = (unsigned)(16 * ct + c16);
        const f32x4 pa = sample_dot<512>((const bf16_t*)(ws + A_YA) + arow * 512u, (const bf16_t*)(ws + WS_WTPA) + (size_t)l * 1024 * 512 + bcol * 512u, g);
        const f32x4 pb = sample_dot<512>((const bf16_t*)(ws + A_YB) + arow * 512u, (const bf16_t*)(ws + WS_WTPB) + (size_t)l * 1024 * 512 + bcol * 512u, g);
        const f32x4 pc = sample_dot<512>((const bf16_t*)(ws + A_YC) + arow * 512u, (const bf16_t*)(ws + WS_WTPC) + (size_t)l * 1024 * 512 + bcol * 512u, g);
        bf16_t* Mb = (bf16_t*)(ws + A_M);
#pragma unroll
        for (int r = 0; r < 4; ++r) { const unsigned o = (unsigned)(RP + 16 * w + 4 * g + r) * 1024u + bcol;
            const float m = bf2f(((const bf16_t*)(ws + A_GA))[o]) * pa[r] + bf2f(((const bf16_t*)(ws + A_GB))[o]) * pb[r] + bf2f(((const bf16_t*)(ws + A_GC))[o]) * pc[r];
            Mb[o] = (bf16_t)f2bf(m); }
    }
}
__device__ __forceinline__ void sample_out(KA a, const Ctx& c, int l, const float* xin_s, float* yout_s) {
    unsigned char* ws = a->ws; const int c16 = c.lane & 15, g = c.lane >> 4, w = c.wave;
    const float* mod = (const float*)(ws + WS_MOD) + (size_t)l * 40 * 3072 + 2048;
    for (int ct = c.bid; ct < 64; ct += c.nblk) {
        const unsigned arow = (unsigned)(RP + 16 * w + c16), bcol = (unsigned)(16 * ct + c16);
        const f32x4 acc = sample_dot<1024>((const bf16_t*)(ws + A_M) + arow * 1024u, (const bf16_t*)(ws + WS_WTOUT) + (size_t)l * 1024 * 1024 + bcol * 1024u, g);
#pragma unroll
        for (int r = 0; r < 4; ++r) { const int sr = 16 * w + 4 * g + r;
            const unsigned o = (unsigned)sr * 1024u + bcol; bf16_t* yb = (bf16_t*)(ws + A_Y0) + (size_t)RP * 1024;
            const float xres = l == 0 ? xin_s[o] : bf2f(yb[o]);
            const float y = xres + mod[(unsigned)(BATCH + (sr >> 2)) * 3072u + bcol] * acc[r];
            if (l == DEPTH - 1) yout_s[o] = y; else yb[o] = (bf16_t)f2bf(y); }
    }
}

struct ProjOrder : pg8::StaticOrder {
    const char* A0; const char* B0;
    __device__ __forceinline__ bool next(int i, pg8::Unit& u) const { if (!pg8::StaticOrder::next(i / 3, u)) return false; u.x = i % 3; return true; }
    __device__ __forceinline__ const char* aptr(const pg8::Gemm&, const pg8::Unit& u, size_t tstep) const { return A0 + (size_t)u.x * (A_YB - A_YA) + (size_t)u.pm * tstep; }
    __device__ __forceinline__ const char* bptr(const pg8::Gemm&, const pg8::Unit& u, size_t tstep) const { return B0 + (size_t)u.x * (WS_WTPB - WS_WTPA) + (size_t)u.pn * tstep; }
};
static_assert(A_YC - A_YB == A_YB - A_YA && WS_WTPC - WS_WTPB == WS_WTPB - WS_WTPA, "equally spaced branch buffers");
struct EpiProjAll {
    static constexpr bool PERM = true, AFTER_DRAIN = false;
    KA a;
    __device__ __forceinline__ void operator()(const f32x4 (&acc)[2][2][4][2], const pg8::Unit& u, int wr, int wc, int fr, int fq) const {
        asm volatile("" : "+v"(fr), "+v"(fq));
        unsigned char* ws = a->ws; const int X = u.x;
        const bf16_t* G = (const bf16_t*)(ws + (X == 0 ? A_GA : (X == 1 ? A_GB : A_GC))); bf16_t* T = (bf16_t*)(ws + A_MT); bf16_t* Mb = (bf16_t*)(ws + A_M);
        const int rbase = u.pm * 256 + wr * 64 + fr, cl = wc * 32 + 8 * fq;
#pragma unroll
        for (int ai = 0; ai < 2; ++ai) {
            int row0 = rbase + ai * 128; asm volatile("" : "+v"(row0));
            const unsigned ob = (unsigned)row0 * 1024u + 256u * u.pn + cl;
            u32x4 gv[4][2], tv[4][2];
#pragma unroll
            for (int m = 0; m < 4; ++m)
#pragma unroll
                for (int bj = 0; bj < 2; ++bj) { const unsigned o = ob + (unsigned)m * 16384u + 128u * bj; gv[m][bj] = *(const u32x4*)(G + o); if (X > 0) tv[m][bj] = *(const u32x4*)(T + o); }
#pragma unroll
            for (int m = 0; m < 4; ++m)
#pragma unroll
                for (int bj = 0; bj < 2; ++bj) { const unsigned o = ob + (unsigned)m * 16384u + 128u * bj;
                    f32x4 g0, g1; unpack8(gv[m][bj], g0, g1);
                    f32x4 v0 = g0 * acc[ai][bj][m][0], v1 = g1 * acc[ai][bj][m][1];
                    if (X > 0) { f32x4 t0, t1; unpack8(tv[m][bj], t0, t1); v0 += t0; v1 += t1; }
                    if (X < 2) *(u32x4*)(T + o) = EpiIn::pack8(v0, v1);
                    else *(u32x4*)(Mb + o) = EpiIn::pack8(v0, v1); }
            asm volatile("" ::: "memory"); __builtin_amdgcn_sched_barrier(0); }
    }
};
__device__ __forceinline__ void phase_proj(KA a, const Ctx& c, int l) {
    ProjOrder S; S.init(RP, 1024, c.nblk, c.bid);
    S.A0 = (const char*)(a->ws + A_YA); S.B0 = (const char*)(a->ws + WS_WTPA) + (size_t)l * 1024 * 512 * 2;
    pg8::Gemm g{(const bf16_t*)S.A0, (const bf16_t*)S.B0, RP, 1024, 512}; EpiProjAll E{a};
    pg8::gemm_phase<EpiProjAll, ProjOrder, true, true>(c.lds_las, g, S, E, c.tid);
}

struct EpiOut {
    static constexpr bool PERM = true, AFTER_DRAIN = false;
    KA a; int l; const float* xin_p; const float* xin_s; float* yout_p; float* yout_s;
    __device__ __forceinline__ void operator()(const f32x4 (&acc)[2][2][4][2], const pg8::Unit& u, int wr, int wc, int fr, int fq) const {
        asm volatile("" : "+v"(fr), "+v"(fq));
        const float* mod = (const float*)(a->ws + WS_MOD) + (size_t)l * 40 * 3072 + 2048;
        const int rbase = u.pm * 256 + wr * 64 + fr, cl = wc * 32 + 8 * fq;
        const float* gr = mod + (unsigned)((u.pm * 256) / SEQ) * 3072u + 256u * u.pn + cl;
        f32x4 gg[2][2];
#pragma unroll
        for (int bj = 0; bj < 2; ++bj) { gg[bj][0] = *(const f32x4*)(gr + 128 * bj); gg[bj][1] = *(const f32x4*)(gr + 128 * bj + 4); }
#pragma unroll
        for (int ai = 0; ai < 2; ++ai) {
            int row0 = rbase + ai * 128; asm volatile("" : "+v"(row0));
            const unsigned ob = (unsigned)row0 * 1024u + 256u * u.pn + cl;
            bf16_t* yb = (bf16_t*)(a->ws + A_Y0);
            f32x4 xv[4][2][2];
            if (l == 0) {
#pragma unroll
                for (int m = 0; m < 4; ++m)
#pragma unroll
                    for (int bj = 0; bj < 2; ++bj) { const float* xr = xin_p + ob + (unsigned)m * 16384u + 128u * bj; xv[m][bj][0] = *(const f32x4*)xr; xv[m][bj][1] = *(const f32x4*)(xr + 4); }
            } else {
                u32x4 xw[4][2];
#pragma unroll
                for (int m = 0; m < 4; ++m)
#pragma unroll
                    for (int bj = 0; bj < 2; ++bj) xw[m][bj] = *(const u32x4*)(yb + ob + (unsigned)m * 16384u + 128u * bj);
#pragma unroll
                for (int m = 0; m < 4; ++m)
#pragma unroll
                    for (int bj = 0; bj < 2; ++bj) unpack8(xw[m][bj], xv[m][bj][0], xv[m][bj][1]);
            }
#pragma unroll
            for (int m = 0; m < 4; ++m)
#pragma unroll
                for (int bj = 0; bj < 2; ++bj) { const unsigned o = ob + (unsigned)m * 16384u + 128u * bj;
                    const f32x4 y0 = xv[m][bj][0] + gg[bj][0] * acc[ai][bj][m][0], y1 = xv[m][bj][1] + gg[bj][1] * acc[ai][bj][m][1];
                    if (l == DEPTH - 1) { __builtin_nontemporal_store(y0, (f32x4*)(yout_p + o)); __builtin_nontemporal_store(y1, (f32x4*)(yout_p + o + 4)); }
                    else *(u32x4*)(yb + o) = EpiIn::pack8(y0, y1); }
            asm volatile("" ::: "memory"); __builtin_amdgcn_sched_barrier(0); }
    }
};
__device__ __forceinline__ void phase_out(KA a, const Ctx& c, int l, const float* xin_p, const float* xin_s, float* yout_p, float* yout_s) {
    sample_out(a, c, l, xin_s, yout_s);
    pg8::Gemm g{(const bf16_t*)(a->ws + A_M), (const bf16_t*)(a->ws + WS_WTOUT) + (size_t)l * 1024 * 1024, RP, 1024, 1024};
    pg8::StaticOrder S; S.init(RP, 1024, c.nblk, c.bid);
    EpiOut E{a, l, xin_p, xin_s, yout_p, yout_s};
    pg8::gemm_phase<EpiOut, pg8::StaticOrder, true, true>(c.lds_las, g, S, E, c.tid);
}

constexpr int N_PHASES = 1 + 6 * DEPTH;
__global__ void __launch_bounds__(NT, 2) fwd_kernel(Args a) {
    extern __shared__ __attribute__((aligned(16))) unsigned char lds[];
    Ctx c; c.tid = threadIdx.x; c.lane = c.tid & 63; c.wave = __builtin_amdgcn_readfirstlane(c.tid >> 6); c.bid = blockIdx.x; c.nblk = gridDim.x; c.lds = lds; c.lds_las = (LAS unsigned char*)lds;
    volatile LAS unsigned* misc = (volatile LAS unsigned*)((LAS unsigned char*)lds + (LDS_BYTES - 64));
    if (c.tid < 16) misc[c.tid] = 0u;
    __syncthreads();
    XcdBarrier bar; bar.bar = (unsigned*)(a.ws + WS_CTL) + 4096; bar.x = 0; bar.st = misc;
    if (a.use_bar) bar = xcd_barrier_post((unsigned*)(a.ws + WS_CTL) + 4096, misc, c.tid);
    const int lo = a.ph_lo, hi = a.ph_hi;
#define IN(k) (lo <= (k) && (k) < hi)
#define SEAM(k) do { if (IN(k) && IN((k) + 1)) xcd_barrier(bar, c.tid); } while (0)
#define PHASE(...) do { KA ka = (KA)__builtin_amdgcn_kernarg_segment_ptr(); asm volatile("" : "+s"(ka)); \
        c.lane = (int)__builtin_amdgcn_mbcnt_hi(~0u, __builtin_amdgcn_mbcnt_lo(~0u, 0u)); c.tid = c.wave * 64 + c.lane;     \
        asm volatile("" : "+v"(c.tid), "+v"(c.lane), "+s"(c.wave), "+s"(c.bid), "+s"(c.nblk)); __VA_ARGS__; } while (0)
    if (IN(0)) { PHASE(phase_pre(ka, c)); SEAM(0); }
#pragma unroll 1
    for (int l_ = 0; l_ < DEPTH; ++l_) {
        int l = l_; asm volatile("" : "+s"(l));
        const int p0 = 1 + 6 * l;
#define XIO const float* xin_p = l == 0 ? ka->x_prompt : (const float*)(ka->ws + A_Y0); const float* xin_s = l == 0 ? ka->x_sample : (const float*)(ka->ws + A_Y0) + (size_t)RP * 1024; \
        float* yout_p = l == DEPTH - 1 ? ka->out + O_YP : (float*)(ka->ws + A_Y0); float* yout_s = l == DEPTH - 1 ? ka->out + O_YS : (float*)(ka->ws + A_Y0) + (size_t)RP * 1024
        if (IN(p0 + 0)) { PHASE(XIO; (void)yout_p; (void)yout_s; phase_norm(ka, c, l, xin_p, xin_s)); SEAM(p0 + 0); }
        if (IN(p0 + 1)) { PHASE(phase_inproj(ka, c, l)); PHASE(hgrn_early(ka, c, l)); SEAM(p0 + 1); }
        if (IN(p0 + 2)) { PHASE(mix_all(ka, c, l)); SEAM(p0 + 2); }
        if (IN(p0 + 3)) { PHASE(phase_attn(ka, c, l)); SEAM(p0 + 3); }
        if (IN(p0 + 4)) { PHASE(phase_proj(ka, c, l)); SEAM(p0 + 4); }
        if (IN(p0 + 5)) { PHASE(XIO; phase_out(ka, c, l, xin_p, xin_s, yout_p, yout_s)); SEAM(p0 + 5); }
    }
#undef IN
#undef SEAM
#undef PHASE
#undef XIO
}

#ifndef N_LAUNCH_MODE
#define N_LAUNCH_MODE 1
#endif
extern "C" void kernel_launch(void* const* d_in, const int* in_sizes, int n_in, void* d_out, int out_size, void* d_ws, size_t ws_size, hipStream_t stream) {
    static int grid = 0;
    if (grid == 0) {
        if (n_in != 26 || (size_t)out_size != O_END || ws_size < WS_NEED) { fprintf(stderr, "kernel_launch: shape mismatch n_in %d out %d ws %zu (need %zu)\n", n_in, out_size, ws_size, (size_t)WS_NEED); grid = -1; return; }
        int dev = 0, cus = 0;
        if (hipGetDevice(&dev) != hipSuccess || hipDeviceGetAttribute(&cus, hipDeviceAttributeMultiprocessorCount, dev) != hipSuccess) { grid = -1; return; }
        if (hipFuncSetAttribute((const void*)fwd_kernel, hipFuncAttributeMaxDynamicSharedMemorySize, LDS_BYTES) != hipSuccess) { grid = -1; return; }
        int per_cu = 0;
        (void)hipOccupancyMaxActiveBlocksPerMultiprocessor(&per_cu, (const void*)fwd_kernel, NT, LDS_BYTES);
        (void)hipGetLastError();
        grid = cus;
    }
    if (grid < 0) return;
    (void)hipMemsetAsync((char*)d_ws + WS_CTL, 0, CTL_ZERO_BYTES, stream);
    Args a{};
    a.x_prompt = (const float*)d_in[0]; a.x_sample = (const float*)d_in[1]; a.cache_k = (const float*)d_in[2]; a.cache_v = (const float*)d_in[3]; a.cache_idx_k = (const float*)d_in[4];
    a.state_conv = (const float*)d_in[5]; a.state_hgrn = (const float*)d_in[6]; a.page_table = (const int*)d_in[7]; a.c_prompt = (const float*)d_in[8]; a.c_sample = (const float*)d_in[9];
    a.w_ada = (const float*)d_in[10]; a.b_ada = (const float*)d_in[11]; a.norm_g = (const float*)d_in[12]; a.w_in = (const float*)d_in[13]; a.w_dw = (const float*)d_in[14];
    a.b_dw = (const float*)d_in[15]; a.ln_g = (const float*)d_in[16]; a.ln_b = (const float*)d_in[17]; a.q_norm_g = (const float*)d_in[18]; a.k_norm_g = (const float*)d_in[19];
    a.lb_logits = (const float*)d_in[20]; a.c_norm_g = (const float*)d_in[21]; a.w_proj_a = (const float*)d_in[22]; a.w_proj_b = (const float*)d_in[23]; a.w_proj_c = (const float*)d_in[24];
    a.w_out = (const float*)d_in[25]; a.out = (float*)d_out; a.ws = (unsigned char*)d_ws;
#if N_LAUNCH_MODE == 1
    a.ph_lo = 0; a.ph_hi = N_PHASES; a.use_bar = 1;
    hipLaunchKernelGGL(fwd_kernel, dim3(grid), dim3(NT), LDS_BYTES, stream, a);
#else
    for (int ph = 0; ph < N_PHASES; ++ph) { a.ph_lo = ph; a.ph_hi = ph + 1; a.use_bar = 0; hipLaunchKernelGGL(fwd_kernel, dim3(grid), dim3(NT), LDS_BYTES, stream, a); }
#endif
}
```
